# Optimizing an MI355X kernel written in HIP

```python
import math
import jax, jax.numpy as jnp
from jax import lax
import numpy as np

D_MODEL = 2048
BATCH = 2
SEQ = 4096
DEPTH = 4

D_MIX = D_MODEL
D_SSD = D_MIX // 2
D_RET = D_MIX - D_SSD
SSD_HEAD_DIM = 64
SSD_HEADS = D_SSD // SSD_HEAD_DIM
SSD_GROUPS = 2
SSD_STATE = 128
SSD_CONV = 4
SSD_XBC = D_SSD + 2 * SSD_GROUPS * SSD_STATE
RET_HEADS = 8
RET_HEAD_DIM = D_RET // RET_HEADS
RET_QK = RET_HEADS * RET_HEAD_DIM
CHUNK = 128
ROPE_BASE = 10000.0
D_FF = 5504
N_MOD = 9
EPS = 1e-6
IN_SPLITS = (D_SSD, SSD_XBC, SSD_HEADS, RET_QK, RET_QK, D_RET, D_RET)
D_IN_PROJ = sum(IN_SPLITS)

kernel_name = "hybrid_ssd_retention_macaron_adaln"


def rms_norm(x, w):
    xf = x.astype(jnp.float32)
    y = xf * lax.rsqrt(jnp.mean(xf * xf, axis=-1, keepdims=True) + EPS)
    return (y * w.astype(jnp.float32)).astype(x.dtype)


def modulate(x, w, shift, scale):
    return rms_norm(x, w) * (1.0 + scale[:, None, :]) + shift[:, None, :]


def swiglu(h, w13, w2):
    a, b = jnp.split(h @ w13, 2, axis=-1)
    return (jax.nn.silu(a) * b) @ w2


def scan_chunk_states(states, decay):
    decay = decay.astype(states.dtype)

    def step(carry, inp):
        s_c, d_c = inp
        return carry * d_c + s_c, carry

    init = jnp.zeros_like(states[:, 0])
    _, prev = lax.scan(step, init, (jnp.moveaxis(states, 1, 0), jnp.moveaxis(decay, 1, 0)))
    return jnp.moveaxis(prev, 0, 1)


def causal_depthwise_conv(x, w, b):
    ch = x.shape[-1]
    y = lax.conv_general_dilated(x, w.reshape(SSD_CONV, 1, ch), window_strides=(1,),
                                 padding=[(SSD_CONV - 1, 0)],
                                 dimension_numbers=("NWC", "WIO", "NWC"),
                                 feature_group_count=ch)
    return y + b


def ssd_chunked(x, dt, A, Bm, Cm):
    bsz, L, h, p = x.shape
    g, n = Bm.shape[-2:]
    r = h // g
    nc = L // CHUNK
    f32 = jnp.float32
    xdt = (x.astype(f32) * dt[..., None]).reshape(bsz, nc, CHUNK, g, r, p)
    a = jnp.transpose((dt * A).reshape(bsz, nc, CHUNK, g, r), (0, 1, 3, 4, 2))
    Bc = Bm.astype(f32).reshape(bsz, nc, CHUNK, g, n)
    Cc = Cm.astype(f32).reshape(bsz, nc, CHUNK, g, n)
    a_cum = jnp.cumsum(a, axis=-1)
    idx = jnp.arange(CHUNK)
    causal = idx[:, None] >= idx[None, :]
    seg = a_cum[..., :, None] - a_cum[..., None, :]
    lmat = jnp.exp(jnp.where(causal, seg, -jnp.inf))
    cb = jnp.einsum("bclgn,bcsgn->bcgls", Cc, Bc)
    y_diag = jnp.einsum("bcgrls,bcsgrp->bclgrp", cb[:, :, :, None] * lmat, xdt)
    decay_states = jnp.exp(a_cum[..., -1:] - a_cum)
    states = jnp.einsum("bclgn,bcgrl,bclgrp->bcgrpn", Bc, decay_states, xdt)
    prev = scan_chunk_states(states, jnp.exp(a_cum[..., -1])[..., None, None])
    y_off = jnp.einsum("bclgn,bcgrpn,bcgrl->bclgrp", Cc, prev, jnp.exp(a_cum))
    return (y_diag + y_off).reshape(bsz, L, h, p).astype(x.dtype)


def ssd_mixer(z, xbc, dt_raw, conv_w, conv_b, dt_bias, a_log, d_skip, norm_w):
    bsz, L, _ = z.shape
    xbc = jax.nn.silu(causal_depthwise_conv(xbc, conv_w, conv_b))
    xs, Bm, Cm = jnp.split(xbc, [D_SSD, D_SSD + SSD_GROUPS * SSD_STATE], axis=-1)
    dt = jax.nn.softplus((dt_raw + dt_bias).astype(jnp.float32))
    A = -jnp.exp(a_log.astype(jnp.float32))
    xh = xs.reshape(bsz, L, SSD_HEADS, SSD_HEAD_DIM)
    y = ssd_chunked(xh, dt, A,
                    Bm.reshape(bsz, L, SSD_GROUPS, SSD_STATE),
                    Cm.reshape(bsz, L, SSD_GROUPS, SSD_STATE))
    y = (y + xh * d_skip[:, None]).reshape(bsz, L, D_SSD)
    return rms_norm(y * jax.nn.silu(z), norm_w)


def rotary(x):
    L, d = x.shape[1], x.shape[-1]
    inv = ROPE_BASE ** (-jnp.arange(0, d, 2, dtype=jnp.float32) / d)
    ang = jnp.arange(L, dtype=jnp.float32)[:, None] * inv[None, :]
    cos, sin = jnp.cos(ang)[None, :, None, :], jnp.sin(ang)[None, :, None, :]
    xf = x.astype(jnp.float32)
    x1, x2 = jnp.split(xf, 2, axis=-1)
    return jnp.concatenate([x1 * cos - x2 * sin, x1 * sin + x2 * cos], axis=-1).astype(x.dtype)


def retention_mixer(q, k, v, gt, gn_w, gn_b):
    bsz, L, _ = q.shape
    nc = L // CHUNK
    dt_ = q.dtype
    q = rotary(q.reshape(bsz, L, RET_HEADS, RET_HEAD_DIM))
    k = rotary(k.reshape(bsz, L, RET_HEADS, RET_HEAD_DIM)) * (RET_HEAD_DIM ** -0.5)
    v = v.reshape(bsz, L, RET_HEADS, RET_HEAD_DIM)
    qc = q.reshape(bsz, nc, CHUNK, RET_HEADS, RET_HEAD_DIM)
    kc = k.reshape(bsz, nc, CHUNK, RET_HEADS, RET_HEAD_DIM)
    vc = v.reshape(bsz, nc, CHUNK, RET_HEADS, RET_HEAD_DIM)
    log_g = jnp.log(1.0 - 2.0 ** (-5.0 - jnp.arange(RET_HEADS, dtype=jnp.float32)))
    idx = jnp.arange(CHUNK, dtype=jnp.float32)
    diff = idx[:, None] - idx[None, :]
    inner_decay = jnp.where(diff >= 0, jnp.exp(jnp.maximum(diff, 0.0)[None] * log_g[:, None, None]), 0.0)
    scores = jnp.einsum("bclhd,bcshd->bchls", qc, kc) * inner_decay.astype(dt_)
    inner = jnp.einsum("bchls,bcshe->bclhe", scores, vc)
    k_decay = jnp.exp((CHUNK - 1.0 - idx)[None, :] * log_g[:, None]).astype(dt_)
    kv = jnp.einsum("bcshd,hs,bcshe->bchde", kc, k_decay, vc)
    chunk_decay = jnp.broadcast_to(jnp.exp(CHUNK * log_g)[None, None, :, None, None],
                                   (bsz, nc, RET_HEADS, 1, 1))
    prev = scan_chunk_states(kv, chunk_decay)
    q_decay = jnp.exp((idx + 1.0)[None, :] * log_g[:, None]).astype(dt_)
    cross = jnp.einsum("bclhd,hl,bchde->bclhe", qc, q_decay, prev)
    o = (inner + cross).reshape(bsz, L, RET_HEADS, RET_HEAD_DIM)
    of = o.astype(jnp.float32)
    mu = jnp.mean(of, axis=-1, keepdims=True)
    var = jnp.mean(jnp.square(of - mu), axis=-1, keepdims=True)
    on = ((of - mu) * lax.rsqrt(var + EPS)).reshape(bsz, L, D_RET)
    on = (on * gn_w.astype(jnp.float32) + gn_b.astype(jnp.float32)).astype(dt_)
    return jax.nn.silu(gt) * on


def setup_inputs(seed: int = 0) -> dict:
    key = jax.random.key(seed)
    ks = jax.random.split(key, 20)
    f32 = jnp.float32
    nrm = lambda k, shape, s: jax.random.normal(k, shape, f32) * s
    dt0 = jnp.exp(jax.random.uniform(ks[9], (DEPTH, SSD_HEADS), f32, math.log(1e-3), math.log(1e-1)))
    return {
        "x": nrm(ks[0], (BATCH, SEQ, D_MODEL), 1.0),
        "c": nrm(ks[1], (BATCH, D_MODEL), 1.0),
        "norm_w": 1.0 + nrm(ks[2], (DEPTH, 3, D_MODEL), 0.02),
        "mod_w": nrm(ks[3], (DEPTH, D_MODEL, N_MOD * D_MODEL), D_MODEL ** -0.5),
        "mod_b": nrm(ks[4], (DEPTH, N_MOD * D_MODEL), 0.02),
        "ffn_w13": nrm(ks[5], (DEPTH, 2, D_MODEL, 2 * D_FF), D_MODEL ** -0.5),
        "ffn_w2": nrm(ks[6], (DEPTH, 2, D_FF, D_MODEL), D_FF ** -0.5),
        "w_in": nrm(ks[7], (DEPTH, D_MODEL, D_IN_PROJ), D_MODEL ** -0.5),
        "conv_w": nrm(ks[8], (DEPTH, SSD_CONV, SSD_XBC), SSD_CONV ** -0.5),
        "conv_b": nrm(ks[10], (DEPTH, SSD_XBC), 0.02),
        "dt_bias": dt0 + jnp.log(-jnp.expm1(-dt0)),
        "a_log": jnp.log(jax.random.uniform(ks[11], (DEPTH, SSD_HEADS), f32, 1.0, 16.0)),
        "d_skip": 1.0 + nrm(ks[12], (DEPTH, SSD_HEADS), 0.02),
        "ssd_norm_w": 1.0 + nrm(ks[13], (DEPTH, D_SSD), 0.02),
        "ret_norm_w": 1.0 + nrm(ks[14], (DEPTH, D_RET), 0.02),
        "ret_norm_b": nrm(ks[15], (DEPTH, D_RET), 0.02),
        "w_out": nrm(ks[16], (DEPTH, D_MIX, D_MODEL), D_MIX ** -0.5),
        "final_norm_w": 1.0 + nrm(ks[17], (D_MODEL,), 0.02),
    }


def reference(x, c, norm_w, mod_w, mod_b, ffn_w13, ffn_w2, w_in, conv_w, conv_b, dt_bias, a_log,
              d_skip, ssd_norm_w, ret_norm_w, ret_norm_b, w_out, final_norm_w):
    split_at = list(np.cumsum(IN_SPLITS)[:-1])
    c_act = jax.nn.silu(c)
    for l in range(DEPTH):
        mods = (c_act @ mod_w[l] + mod_b[l]).reshape(c.shape[0], N_MOD, D_MODEL)
        h = modulate(x, norm_w[l, 0], mods[:, 0], mods[:, 1])
        x = x + 0.5 * mods[:, 2][:, None, :] * swiglu(h, ffn_w13[l, 0], ffn_w2[l, 0])
        h = modulate(x, norm_w[l, 1], mods[:, 3], mods[:, 4])
        z, xbc, dt_raw, q, k, v, gt = jnp.split(h @ w_in[l], split_at, axis=-1)
        y_ssd = ssd_mixer(z, xbc, dt_raw, conv_w[l], conv_b[l], dt_bias[l], a_log[l], d_skip[l],
                          ssd_norm_w[l])
        y_ret = retention_mixer(q, k, v, gt, ret_norm_w[l], ret_norm_b[l])
        mix = jnp.concatenate([y_ssd, y_ret], axis=-1) @ w_out[l]
        x = x + mods[:, 5][:, None, :] * mix
        h = modulate(x, norm_w[l, 2], mods[:, 6], mods[:, 7])
        x = x + 0.5 * mods[:, 8][:, None, :] * swiglu(h, ffn_w13[l, 1], ffn_w2[l, 1])
    return rms_norm(x, final_norm_w)
```

```cpp
#include <hip/hip_runtime.h>
#include <cstdio>
#include <cstdint>
namespace pg8 {
#define PG8_LAS __attribute__((address_space(3)))
typedef unsigned short bf16_t;
typedef short bf16x8 __attribute__((ext_vector_type(8)));
typedef float f32x4 __attribute__((ext_vector_type(4)));
typedef unsigned u32x4 __attribute__((ext_vector_type(4)));
constexpr int BM = 256, BK = 64, HALF = 128, HTB = HALF * BK * 2  , STAGE_BYTES = 8 * HTB, NXCD = 8, WGM = 8;

__host__ __device__ __forceinline__ int lds_byte(int r, int c) { const int st = (r >> 4) * 2 + (c >> 5), rr = r & 15, cc = c & 31, ob = rr * 64 + cc * 2; return st * 1024 + (ob ^ (((ob >> 9) & 1) << 5)); }
__host__ __device__ __forceinline__ void stage_rc(int b, int& R, int& C) { const int st = b / 1024, sb = b % 1024, swz = sb ^ (((sb >> 9) & 1) << 5); R = (st >> 1) * 16 + swz / 64; C = (st & 1) * 32 + (swz % 64) / 2; }
__host__ __device__ __forceinline__ int perm32(int rho) { const int n = rho >> 4, i = rho & 15; return 8 * (i >> 2) + 4 * n + (i & 3); }

struct Unit { int pm, pn; };
struct Gemm { const bf16_t* A; const bf16_t* Bt; int M, N, K; };

struct StaticOrder {
    int nM, nN, nwg, G, c;
    __host__ __device__ void init(int M, int N, int G_, int c_) { nM = M / BM; nN = N / BM; nwg = nM * nN; G = G_; c = c_; }
    __host__ __device__ bool next(int i, Unit& u) const {
        const long L = (long)i * G + c; if (L >= nwg) return false;
        int wgid = (int)L; { const int q = nwg / NXCD, r = nwg % NXCD, xcd = wgid % NXCD, off = wgid / NXCD; wgid = (xcd < r ? xcd * (q + 1) : r * (q + 1) + (xcd - r) * q) + off; }
        const int nig = WGM * nN, gid = wgid / nig, fm = gid * WGM, gsz = (nM - fm) < WGM ? (nM - fm) : WGM;
        u.pm = fm + ((wgid % nig) % gsz); u.pn = (wgid % nig) / gsz; return true;
    }
    __device__ __forceinline__ void a_ready(const Unit&) const {}
    __device__ __forceinline__ void done(const Unit&) const {}
};
__device__ __forceinline__ unsigned cvt_pk_bf16(float lo, float hi) { unsigned r; asm volatile("v_cvt_pk_bf16_f32 %0, %1, %2" : "=v"(r) : "v"(lo), "v"(hi)); return r; }
typedef float f32x2 __attribute__((ext_vector_type(2)));
typedef float f32x2 __attribute__((ext_vector_type(2)));
__device__ __forceinline__ float silu_f(float a) { return a * __builtin_amdgcn_rcpf(1.0f + __builtin_amdgcn_exp2f(-1.4426950408889634f * a)); }

struct EpiBf16 {
    static constexpr bool PERM = true, AFTER_DRAIN = false;
    bf16_t* O; int ldc;
    __device__ __forceinline__ void operator()(const f32x4 (&acc)[2][2][4][2], const Unit& u, int wr, int wc, int fr, int fq) const {
        const int row0 = u.pm * BM + wr * 64 + fr, col0 = u.pn * BM + wc * 32 + 8 * fq;
#pragma unroll
        for (int ai = 0; ai < 2; ++ai)
#pragma unroll
            for (int m = 0; m < 4; ++m) { bf16_t* rowp = O + (size_t)(row0 + ai * HALF + m * 16) * ldc + col0;
#pragma unroll
                for (int bj = 0; bj < 2; ++bj) { const f32x4 v0 = acc[ai][bj][m][0], v1 = acc[ai][bj][m][1];
                    u32x4 w; w.x = cvt_pk_bf16(v0[0], v0[1]); w.y = cvt_pk_bf16(v0[2], v0[3]); w.z = cvt_pk_bf16(v1[0], v1[1]); w.w = cvt_pk_bf16(v1[2], v1[3]);
                    *(u32x4*)(rowp + bj * HALF) = w; } }
    }
};
struct EpiSwiGLU {
    static constexpr bool PERM = true, AFTER_DRAIN = false;
    bf16_t* O; int ldc;
    __device__ __forceinline__ void operator()(const f32x4 (&acc)[2][2][4][2], const Unit& u, int wr, int wc, int fr, int fq) const {
        const int row0 = u.pm * BM + wr * 64 + fr, col0 = u.pn * HALF + wc * 32 + 8 * fq;
#pragma unroll
        for (int ai = 0; ai < 2; ++ai)
#pragma unroll
            for (int m = 0; m < 4; ++m) { bf16_t* rowp = O + (size_t)(row0 + ai * HALF + m * 16) * ldc + col0;
                const f32x4 a0 = acc[ai][0][m][0], a1 = acc[ai][0][m][1], b0 = acc[ai][1][m][0], b1 = acc[ai][1][m][1];
                u32x4 w;
                w.x = cvt_pk_bf16(silu_f(a0[0]) * b0[0], silu_f(a0[1]) * b0[1]); w.y = cvt_pk_bf16(silu_f(a0[2]) * b0[2], silu_f(a0[3]) * b0[3]);
                w.z = cvt_pk_bf16(silu_f(a1[0]) * b1[0], silu_f(a1[1]) * b1[1]); w.w = cvt_pk_bf16(silu_f(a1[2]) * b1[2], silu_f(a1[3]) * b1[3]);
                *(u32x4*)rowp = w; }
    }
};
struct EpiResid {
    static constexpr bool PERM = false, AFTER_DRAIN = false;
    const float* xin; float* xout; int ldc; const float* gate; int gstride; int rows_per_batch; float gs;
    __device__ __forceinline__ void operator()(const f32x4 (&acc)[2][2][4][2], const Unit& u, int wr, int wc, int fr, int fq) const {
        const int row0 = u.pm * BM + wr * 64 + fr, col0 = u.pn * BM + wc * 32 + 4 * fq;
        const float* g = gate + (size_t)((u.pm * BM) / rows_per_batch) * gstride;
        f32x4 gv[2][2];
#pragma unroll
        for (int bj = 0; bj < 2; ++bj)
#pragma unroll
            for (int n = 0; n < 2; ++n) gv[bj][n] = *(const f32x4*)(g + col0 + bj * HALF + n * 16) * gs;
#pragma unroll
        for (int ai = 0; ai < 2; ++ai)
#pragma unroll
            for (int m = 0; m < 4; ++m) { const size_t off = (size_t)(row0 + ai * HALF + m * 16) * ldc + col0;
#pragma unroll
                for (int bj = 0; bj < 2; ++bj)
#pragma unroll
                    for (int n = 0; n < 2; ++n) { const f32x4 xv = *(const f32x4*)(xin + off + bj * HALF + n * 16);
                        *(f32x4*)(xout + off + bj * HALF + n * 16) = xv + gv[bj][n] * acc[ai][bj][m][n]; } }
    }
};

template <class Epi, class Sched, bool ALIGN_EPI = false, bool SP2 = false>
__device__ __forceinline__ void gemm_phase(PG8_LAS unsigned char* lds, const Gemm g, const Sched& S, const Epi& E) {
    int tid_ = threadIdx.x; asm volatile("" : "+v"(tid_)); const int tid = tid_, wid = __builtin_amdgcn_readfirstlane(tid >> 6), lane = tid & 63, wr = wid >> 2, wc = wid & 3, fr = lane & 15, fq = lane >> 4;
    const int K = g.K, nt = K / BK;
    unsigned voffA[2], voffB[2];
#pragma unroll
    for (int i = 0; i < 2; ++i) { int R, C; stage_rc(tid * 16 + i * 8192, R, C); const int Rb = Epi::PERM ? ((R & ~31) + perm32(R & 31)) : R;
        voffA[i] = (unsigned)(R * K + C) * 2u; voffB[i] = (unsigned)(Rb * K + C) * 2u; }
    const size_t kstep = (size_t)(BK * 2);
    const size_t hstep = (size_t)HALF * K * 2;
    const size_t tstep = 2 * hstep;
    const unsigned ldsw = (unsigned)wid * 1024u;
    const int aoff = lds_byte(wr * 64 + fr, fq * 8), boff = lds_byte(wc * 32 + fr, fq * 8);
#define PG8_SA(b, h) (((b) * 2 + (h)) * HTB)
#define PG8_SB(b, h) ((4 + (b) * 2 + (h)) * HTB)
#define PG8_STAGE(bufoff, gbase, voff) do { _Pragma("unroll") for (int _i = 0; _i < 2; ++_i) \
        __builtin_amdgcn_global_load_lds((const unsigned*)((const char*)(gbase) + (voff)[_i]), (PG8_LAS unsigned*)(lds + (bufoff) + ldsw + _i * 8192), 16, 0, 0); } while (0)
#define PG8_LDA(dst, b, h) do { _Pragma("unroll") for (int m = 0; m < 4; ++m) _Pragma("unroll") for (int k = 0; k < 2; ++k) dst[m][k] = *(const PG8_LAS bf16x8*)(lds + PG8_SA(b, h) + aoff + m * 2048 + k * 1024); } while (0)
#define PG8_LDB(dst, b, h) do { _Pragma("unroll") for (int n = 0; n < 2; ++n) _Pragma("unroll") for (int k = 0; k < 2; ++k) dst[n][k] = *(const PG8_LAS bf16x8*)(lds + PG8_SB(b, h) + boff + n * 2048 + k * 1024); } while (0)
#define PG8_MMA(ai, bj, At, Bt) do { __builtin_amdgcn_s_setprio(1); _Pragma("unroll") for (int m = 0; m < 4; ++m) _Pragma("unroll") for (int n = 0; n < 2; ++n) _Pragma("unroll") for (int k = 0; k < 2; ++k) \
        acc[ai][bj][m][n] = __builtin_amdgcn_mfma_f32_16x16x32_bf16(Bt[n][k], At[m][k], acc[ai][bj][m][n], 0, 0, 0); __builtin_amdgcn_s_setprio(0); } while (0)
#define PG8_WAIT_V(n) asm volatile("s_waitcnt vmcnt(" #n ")" ::: "memory")
#define PG8_WAIT_L(n) asm volatile("s_waitcnt lgkmcnt(" #n ")" ::: "memory")
#define PG8_BAR __builtin_amdgcn_s_barrier()
#define PG8_SCHED __builtin_amdgcn_sched_barrier(0)
    Unit cur, nxt; int ui = 0;
    if (!S.next(0, cur)) return;
    f32x4 acc[2][2][4][2];
#pragma unroll
    for (int a = 0; a < 2; ++a)
#pragma unroll
        for (int b = 0; b < 2; ++b)
#pragma unroll
            for (int m = 0; m < 4; ++m)
#pragma unroll
                for (int n = 0; n < 2; ++n) acc[a][b][m][n] = (f32x4){0.f, 0.f, 0.f, 0.f};
    bf16x8 At[4][2], B0[2][2], B1[2][2];
    const char* cA = (const char*)g.A + (size_t)cur.pm * tstep; const char* cB = (const char*)g.Bt + (size_t)cur.pn * tstep;
    S.a_ready(cur);
    if constexpr (SP2) {
        PG8_STAGE(PG8_SB(0, 0), cB, voffB); PG8_STAGE(PG8_SB(0, 1), cB + hstep, voffB); PG8_STAGE(PG8_SA(0, 0), cA, voffA); PG8_STAGE(PG8_SA(0, 1), cA + hstep, voffA);
        if (wr == 1) PG8_BAR;
        PG8_WAIT_V(2); PG8_BAR;
        PG8_STAGE(PG8_SB(1, 0), cB + kstep, voffB); PG8_STAGE(PG8_SA(1, 0), cA + kstep, voffA); PG8_STAGE(PG8_SB(1, 1), cB + hstep + kstep, voffB);
        PG8_WAIT_V(6); PG8_BAR;
    } else {
        PG8_STAGE(PG8_SB(0, 0), cB, voffB); PG8_STAGE(PG8_SA(0, 0), cA, voffA); PG8_STAGE(PG8_SB(0, 1), cB + hstep, voffB); PG8_STAGE(PG8_SA(0, 1), cA + hstep, voffA);
        if (wr == 1) PG8_BAR;
        PG8_WAIT_V(4); PG8_BAR;
        PG8_STAGE(PG8_SB(1, 0), cB + kstep, voffB); PG8_STAGE(PG8_SA(1, 0), cA + kstep, voffA); PG8_STAGE(PG8_SB(1, 1), cB + hstep + kstep, voffB);
        PG8_WAIT_V(6); PG8_BAR;
    }
    for (;;) {
        const bool has_next = S.next(ui + 1, nxt);
        const char* nA = has_next ? (const char*)g.A + (size_t)nxt.pm * tstep : cA; const char* nB = has_next ? (const char*)g.Bt + (size_t)nxt.pn * tstep : cB;
        for (int t = 0; t < nt; t += 2) {
            const bool last = (t == nt - 2);
            const char* a1 = cA + (size_t)(t + 1) * kstep;
            const char* a2 = last ? nA : cA + (size_t)(t + 2) * kstep; const char* b2 = last ? nB : cB + (size_t)(t + 2) * kstep;
            const char* a3 = a2 + kstep; const char* b3 = b2 + kstep;
            if (last && has_next) S.a_ready(nxt);
            if constexpr (SP2) {
            PG8_LDB(B0, 0, 0); PG8_LDB(B1, 0, 1); PG8_SCHED; PG8_LDA(At, 0, 0); PG8_STAGE(PG8_SA(1, 1), a1 + hstep, voffA);
            PG8_WAIT_V(8); PG8_WAIT_L(0); PG8_BAR; PG8_MMA(0, 0, At, B0); PG8_MMA(0, 1, At, B1); PG8_BAR; PG8_SCHED;
            PG8_LDA(At, 0, 1); PG8_STAGE(PG8_SB(0, 0), b2, voffB); PG8_STAGE(PG8_SB(0, 1), b2 + hstep, voffB); PG8_STAGE(PG8_SA(0, 0), a2, voffA);
            PG8_WAIT_V(8); PG8_WAIT_L(0); PG8_BAR; PG8_MMA(1, 0, At, B0); PG8_MMA(1, 1, At, B1); PG8_BAR; PG8_SCHED;
            PG8_LDB(B0, 1, 0); PG8_LDB(B1, 1, 1); PG8_SCHED; PG8_LDA(At, 1, 0); PG8_STAGE(PG8_SA(0, 1), a2 + hstep, voffA);
            PG8_WAIT_V(8); PG8_WAIT_L(0); PG8_BAR; PG8_MMA(0, 0, At, B0); PG8_MMA(0, 1, At, B1); PG8_BAR; PG8_SCHED;
            PG8_LDA(At, 1, 1); PG8_STAGE(PG8_SB(1, 0), b3, voffB); PG8_STAGE(PG8_SB(1, 1), b3 + hstep, voffB); PG8_STAGE(PG8_SA(1, 0), a3, voffA);
            PG8_WAIT_V(8); PG8_WAIT_L(0); PG8_BAR; PG8_MMA(1, 0, At, B0); PG8_MMA(1, 1, At, B1); PG8_BAR; PG8_SCHED;
            } else {
            PG8_LDB(B0, 0, 0); PG8_SCHED; PG8_LDA(At, 0, 0); PG8_STAGE(PG8_SA(1, 1), a1 + hstep, voffA);
            PG8_WAIT_L(8); PG8_BAR; PG8_WAIT_L(0); PG8_MMA(0, 0, At, B0); PG8_BAR; PG8_SCHED;
            PG8_LDB(B1, 0, 1); PG8_STAGE(PG8_SB(0, 0), b2, voffB);
            PG8_BAR; PG8_WAIT_L(0); PG8_MMA(0, 1, At, B1); PG8_BAR;
            PG8_LDA(At, 0, 1); PG8_STAGE(PG8_SA(0, 0), a2, voffA);
            PG8_BAR; PG8_WAIT_L(0); PG8_MMA(1, 0, At, B0); PG8_BAR; PG8_SCHED;
            PG8_STAGE(PG8_SB(0, 1), b2 + hstep, voffB);
            PG8_WAIT_V(6); PG8_BAR; PG8_MMA(1, 1, At, B1); PG8_BAR;
            PG8_LDB(B0, 1, 0); PG8_SCHED; PG8_LDA(At, 1, 0); PG8_STAGE(PG8_SA(0, 1), a2 + hstep, voffA);
            PG8_WAIT_L(8); PG8_BAR; PG8_WAIT_L(0); PG8_MMA(0, 0, At, B0); PG8_BAR; PG8_SCHED;
            PG8_LDB(B1, 1, 1); PG8_STAGE(PG8_SB(1, 0), b3, voffB);
            PG8_BAR; PG8_WAIT_L(0); PG8_MMA(0, 1, At, B1); PG8_BAR;
            PG8_LDA(At, 1, 1); PG8_STAGE(PG8_SA(1, 0), a3, voffA);
            PG8_BAR; PG8_WAIT_L(0); PG8_MMA(1, 0, At, B0); PG8_BAR; PG8_SCHED;
            PG8_STAGE(PG8_SB(1, 1), b3 + hstep, voffB);
            PG8_WAIT_V(6); PG8_BAR; PG8_MMA(1, 1, At, B1); PG8_BAR;
            }
        }
        if constexpr (ALIGN_EPI) { if (wr == 0) PG8_BAR; }
        if constexpr (!Epi::AFTER_DRAIN) { E(acc, cur, wr, wc, fr, fq); S.done(cur); }
        if (!has_next) break;
#pragma unroll
        for (int a = 0; a < 2; ++a)
#pragma unroll
            for (int b = 0; b < 2; ++b)
#pragma unroll
                for (int m = 0; m < 4; ++m)
#pragma unroll
                    for (int n = 0; n < 2; ++n) acc[a][b][m][n] = (f32x4){0.f, 0.f, 0.f, 0.f};
        cur = nxt; cA = nA; cB = nB; ++ui;
        if constexpr (ALIGN_EPI) { if (wr == 1) PG8_BAR; }
    }
    PG8_WAIT_V(0);
    if constexpr (!ALIGN_EPI) { if (wr == 0) PG8_BAR; }
    PG8_BAR;
    if constexpr (Epi::AFTER_DRAIN) { E.fused(acc, cur, wr, wc, fr, fq, lds, wid, lane); S.done(cur); }
#undef PG8_SA
#undef PG8_SB
#undef PG8_STAGE
#undef PG8_LDA
#undef PG8_LDB
#undef PG8_MMA
#undef PG8_WAIT_V
#undef PG8_WAIT_L
#undef PG8_BAR
#undef PG8_SCHED
}
}

constexpr int NWAVES = 8, NTHR = 512;
constexpr int DM = 2048, NBATCH = 2, SEQ = 4096, MROWS = NBATCH * SEQ, DEPTH = 4;
constexpr int DFF = 5504, DFF2 = 2 * DFF;
constexpr int DSSD = 1024, NXBC = 1536, NHS = 16, HDS = 64, NST = 128;
constexpr int NHR = 8, HDR = 128;
constexpr int DIN = 6672, DINP = 6912;
constexpr int CHUNK = 128, NCH = MROWS / CHUNK;
constexpr int NMOD = 9, MODW = NMOD * DM;
constexpr float EPS = 1e-6f;
constexpr int PZ = 0, PX = 1024, PB = 2048, PC = 2304, PQ = 2560, PK = 3584, PV = 4608, PG = 5632, PDT = 6656;

constexpr size_t MiB = 1u << 20;
constexpr size_t WS_CTL = 0, CTL_ZERO_BYTES = 1 * MiB;
constexpr size_t WS_MODS = 1 * MiB;
constexpr size_t WS_ROPE = 2 * MiB;
constexpr size_t WS_DTV = 4 * MiB;
constexpr size_t WS_ACUM = WS_DTV + 512 * 1024;
constexpr size_t WS_SSQ = WS_ACUM + 512 * 1024;
constexpr size_t WS_HN = 8 * MiB;
constexpr size_t WS_YMIX = 40 * MiB;
constexpr size_t WS_H1 = 72 * MiB;
constexpr size_t WS_PROJ = 160 * MiB;
constexpr size_t WS_XBCC = 268 * MiB;
constexpr size_t WS_SST = 292 * MiB;
constexpr size_t WS_SSTP = 324 * MiB;
constexpr size_t WS_KV = 356 * MiB;
constexpr size_t WS_KVP = 388 * MiB;
constexpr size_t WS_W = 420 * MiB;
constexpr size_t W13_BYTES = (size_t)DFF2 * DM * 2, W2_BYTES = (size_t)DM * DFF * 2, WIN_BYTES = (size_t)DINP * DM * 2, WOUT_BYTES = (size_t)DM * DM * 2;
constexpr size_t WL_W13 = 0, WL_W2 = 2 * W13_BYTES, WL_WIN = WL_W2 + 2 * W2_BYTES, WL_WOUT = WL_WIN + WIN_BYTES, WL_BYTES = WL_WOUT + WOUT_BYTES;
constexpr size_t WS_END = WS_W + DEPTH * WL_BYTES;
static_assert(WS_H1 + (size_t)MROWS * DFF * 2 <= WS_PROJ && WS_PROJ + (size_t)MROWS * DINP * 2 <= WS_XBCC && WS_XBCC + (size_t)MROWS * NXBC * 2 <= WS_SST, "ws map");
static_assert(W13_BYTES % 256 == 0 && W2_BYTES % 256 == 0 && WIN_BYTES % 256 == 0, "weight alignment");
constexpr int CW_BAR = 4096;

constexpr int LDS_BYTES = 147456;
constexpr int MISC_OFF = 145408;

#define GAS __attribute__((address_space(1)))
#define LAS __attribute__((address_space(3)))
typedef unsigned short bf16;
typedef unsigned v4u __attribute__((ext_vector_type(4)));
typedef unsigned v2u __attribute__((ext_vector_type(2)));
typedef float f32x4 __attribute__((ext_vector_type(4)));
typedef float f32x2v __attribute__((ext_vector_type(2)));
typedef short bf16x8 __attribute__((ext_vector_type(8)));
typedef short s16x4 __attribute__((ext_vector_type(4)));
typedef GAS unsigned gu32;
#define RLX_AGENT __ATOMIC_RELAXED, __HIP_MEMORY_SCOPE_AGENT
#define LDS_WAIT() asm volatile("s_waitcnt lgkmcnt(0)" ::: "memory")
#define VM_WAIT() asm volatile("s_waitcnt vmcnt(0)" ::: "memory")
__device__ __forceinline__ unsigned pkbf(float lo, float hi) { unsigned r; asm volatile("v_cvt_pk_bf16_f32 %0, %1, %2" : "=v"(r) : "v"(lo), "v"(hi)); return r; }
__device__ __forceinline__ float bflo(unsigned w) { return __builtin_bit_cast(float, w << 16); }
__device__ __forceinline__ float bfhi(unsigned w) { return __builtin_bit_cast(float, w & 0xffff0000u); }
__device__ __forceinline__ float bf1(bf16 h) { return __builtin_bit_cast(float, (unsigned)h << 16); }
__device__ __forceinline__ float silu(float a) { return a * __builtin_amdgcn_rcpf(1.0f + __builtin_amdgcn_exp2f(-1.4426950408889634f * a)); }
__device__ __forceinline__ float fexp(float x) { return __builtin_amdgcn_exp2f(1.4426950408889634f * x); }
__device__ __forceinline__ float wave_sum(float v) {
#pragma unroll
    for (int o = 1; o < 64; o <<= 1) v += __shfl_xor(v, o);
    return v;
}
__device__ __forceinline__ float sum16(float v) {
#pragma unroll
    for (int o = 1; o < 16; o <<= 1) v += __shfl_xor(v, o);
    return v;
}
__device__ __forceinline__ bf16x8 frag_row(const LAS unsigned char* base, int stride, int row0, int k0, int lane) {
    return *(const LAS bf16x8*)(base + (row0 + (lane & 15)) * stride + (k0 + 8 * (lane >> 4)) * 2);
}
__device__ __forceinline__ bf16x8 frag_tr(const LAS unsigned char* base, int stride, int k0, int n0, int lane) {
    const int q = lane >> 4, i = lane & 15;
    const LAS unsigned char* p = base + (k0 + 8 * q + (i >> 2)) * stride + (n0 + 4 * (i & 3)) * 2;
    const s16x4 a = __builtin_amdgcn_ds_read_tr16_b64_v4i16((LAS s16x4*)p);
    const s16x4 b = __builtin_amdgcn_ds_read_tr16_b64_v4i16((LAS s16x4*)(p + 4 * stride));
    return (bf16x8){a[0], a[1], a[2], a[3], b[0], b[1], b[2], b[3]};
}
#define MFMA16(a, b, c) __builtin_amdgcn_mfma_f32_16x16x32_bf16((a), (b), (c), 0, 0, 0)

#define XB_TMO      128
#define XB_XCNT(j)  (256  + 64 * (j))
#define XB_XSUB(j)  (1280 + 64 * (j))
#define XB_XGEN(j)  (2304 + 64 * (j))
#define XB_TOP      3328
#define XB_TOPGEN   3392
#define XCD_BAR_WORDS 3456
#define XB_SPIN_CAP (1u << 18)

__device__ __forceinline__ unsigned xb_ld(unsigned* p)              { return __hip_atomic_load(p, __ATOMIC_RELAXED, __HIP_MEMORY_SCOPE_AGENT); }
__device__ __forceinline__ unsigned xb_add(unsigned* p, unsigned v) { return __hip_atomic_fetch_add(p, v, __ATOMIC_RELAXED, __HIP_MEMORY_SCOPE_AGENT); }
__device__ __forceinline__ unsigned xb_xcc_id() { return (unsigned)__builtin_amdgcn_s_getreg((3 << 11) | 20) & 0xFu; }
#define XB_SPIN(cond, bar) do { unsigned _sp = 0; while (cond) { __builtin_amdgcn_s_sleep(1); \
    if ((++_sp & 255u) == 0u) { if (xb_ld(&(bar)[XB_TMO])) break; if (_sp > XB_SPIN_CAP) { atomicAdd(&(bar)[XB_TMO], 1u); break; } } } } while (0)

struct XcdBarrier {
    unsigned* bar; unsigned x;
    volatile LAS unsigned* st;
};

__device__ __forceinline__ XcdBarrier xcd_barrier_post(unsigned* bar, volatile LAS unsigned* st) {
    XcdBarrier b; b.bar = bar; b.x = xb_xcc_id(); b.st = st;
    if (threadIdx.x == 0) (void)xb_add(&bar[XB_XCNT(b.x)], 1u);
    return b;
}
__device__ __forceinline__ void xcd_barrier_complete(unsigned* bar, unsigned x, unsigned& nloc, unsigned& nx) {
    const unsigned G = gridDim.x * gridDim.y * gridDim.z;
    unsigned sum, cnt, mine, sp = 0u;
    for (;;) {
        sum = 0u; cnt = 0u; mine = 0u;
#pragma unroll
        for (unsigned j = 0; j < 16; ++j) { const unsigned c = xb_ld(&bar[XB_XCNT(j)]); sum += c; cnt += (c > 0u) ? 1u : 0u; mine = (j == x) ? c : mine; }
        if (sum == G) break;
        __builtin_amdgcn_s_sleep(1);
        if ((++sp & 255u) == 0u) { if (xb_ld(&bar[XB_TMO])) break; if (sp > XB_SPIN_CAP) { atomicAdd(&bar[XB_TMO], 1u); break; } }
    }
    nloc = mine > 0u ? mine : 1u; nx = cnt > 0u ? cnt : 1u;
}

__device__ __forceinline__ void xcd_barrier(const XcdBarrier& b) {
    asm volatile("s_waitcnt vmcnt(0)" ::: "memory");
    __syncthreads();
    if (threadIdx.x == 0) {
        unsigned* bar = b.bar;
        __builtin_amdgcn_s_waitcnt(0);
        unsigned nloc = b.st[0], nx = b.st[1];
        if (nloc == 0u) { xcd_barrier_complete(bar, b.x, nloc, nx); b.st[0] = nloc; b.st[1] = nx; }
        const unsigned old = xb_add(&bar[XB_XSUB(b.x)], 1u);
        const unsigned gen = old / nloc;
        if (old + 1u == (gen + 1u) * nloc) {
            __builtin_amdgcn_fence(__ATOMIC_RELEASE, "agent");
            asm volatile("s_waitcnt vmcnt(0)" ::: "memory");
            const unsigned og = xb_add(&bar[XB_TOP], 1u);
            const unsigned tg = og / nx;
            if (og + 1u == (tg + 1u) * nx) xb_add(&bar[XB_TOPGEN], 1u);
            else XB_SPIN(xb_ld(&bar[XB_TOPGEN]) == tg, bar);
            __builtin_amdgcn_fence(__ATOMIC_ACQUIRE, "agent");
            xb_add(&bar[XB_XGEN(b.x)], 1u);
            asm volatile("s_waitcnt vmcnt(0)" ::: "memory");
        } else {
            XB_SPIN(xb_ld(&bar[XB_XGEN(b.x)]) == gen, bar);
            __builtin_amdgcn_fence(__ATOMIC_ACQUIRE, "agent");
            asm volatile("s_waitcnt vmcnt(0)" ::: "memory");
        }
    }
    __syncthreads();
}

struct Frame {
    LAS unsigned char* lds;
    int tid, lane, wave, vcu, G;
    unsigned char* ws;
    const float* in[18];
    float* out;
};
__device__ __forceinline__ void fresh(Frame& F) { int t = threadIdx.x; asm volatile("" : "+v"(t)); F.tid = t; F.lane = t & 63; F.wave = __builtin_amdgcn_readfirstlane(t >> 6); }
enum { I_X = 0, I_C, I_NORMW, I_MODW, I_MODB, I_W13, I_W2, I_WIN, I_CONVW, I_CONVB, I_DTB, I_ALOG, I_DSKIP, I_SSDNW, I_RETNW, I_RETNB, I_WOUT, I_FNW };

__device__ __forceinline__ void cvt_tile(const float* W, int N, bf16* WT, int K, int kb, int nb, int src_col, int nvalid, LAS float* scr, int lane) {
    const int k0 = 64 * kb, n0 = 32 * nb, c = lane & 31;
#pragma unroll 8
    for (int i = 0; i < 32; ++i) { const int kk = 2 * i + (lane >> 5); float v = 0.f; if (c < nvalid) v = W[(size_t)(k0 + kk) * N + src_col + c]; scr[kk * 33 + c] = v; }
    LDS_WAIT(); asm volatile("" ::: "memory");
    const int cch = lane & 7;
#pragma unroll
    for (int j = 0; j < 4; ++j) { const int n = (lane >> 3) + 8 * j; const LAS float* s = scr + (8 * cch) * 33 + n;
        v4u o; o.x = pkbf(s[0 * 33], s[1 * 33]); o.y = pkbf(s[2 * 33], s[3 * 33]); o.z = pkbf(s[4 * 33], s[5 * 33]); o.w = pkbf(s[6 * 33], s[7 * 33]);
        *(GAS v4u*)(WT + (size_t)(n0 + n) * K + k0 + 8 * cch) = o; }
    LDS_WAIT(); asm volatile("" ::: "memory");
}
constexpr int IT_W13 = (DM / 64) * (DFF2 / 32), IT_W2 = (DFF / 64) * (DM / 32), IT_WIN = (DM / 64) * (DINP / 32), IT_WOUT = (DM / 64) * (DM / 32);
constexpr int IT_LAYER = 2 * IT_W13 + 2 * IT_W2 + IT_WIN + IT_WOUT, IT_ALL = DEPTH * IT_LAYER;
__device__ __forceinline__ void cvt_item(Frame& F, int it, LAS float* scr) {
    const int l = it / IT_LAYER; int r = it % IT_LAYER;
    unsigned char* wl = F.ws + WS_W + (size_t)l * WL_BYTES;
    if (r < 2 * IT_W13) { const int f = r / IT_W13, r2 = r % IT_W13, kb = r2 / (DFF2 / 32), nb = r2 % (DFF2 / 32);
        const int T = nb >> 3, hf = (nb >> 2) & 1, sub = nb & 3;
        cvt_tile(F.in[I_W13] + (size_t)(l * 2 + f) * DM * DFF2, DFF2, (bf16*)(wl + WL_W13 + (size_t)f * W13_BYTES), DM, kb, nb, hf * DFF + T * 128 + sub * 32, 32, scr, F.lane); return; }
    r -= 2 * IT_W13;
    if (r < 2 * IT_W2) { const int f = r / IT_W2, r2 = r % IT_W2, kb = r2 / (DM / 32), nb = r2 % (DM / 32);
        cvt_tile(F.in[I_W2] + (size_t)(l * 2 + f) * DFF * DM, DM, (bf16*)(wl + WL_W2 + (size_t)f * W2_BYTES), DFF, kb, nb, 32 * nb, 32, scr, F.lane); return; }
    r -= 2 * IT_W2;
    if (r < IT_WIN) { const int kb = r / (DINP / 32), nb = r % (DINP / 32);
        int src = 32 * nb, nv = 32;
        if (nb >= 80 && nb < 208) src = 32 * nb + 16; else if (nb == 208) { src = 2560; nv = 16; } else if (nb > 208) { src = 0; nv = 0; }
        cvt_tile(F.in[I_WIN] + (size_t)l * DM * DIN, DIN, (bf16*)(wl + WL_WIN), DM, kb, nb, src, nv, scr, F.lane); return; }
    r -= IT_WIN;
    { const int kb = r / (DM / 32), nb = r % (DM / 32);
      cvt_tile(F.in[I_WOUT] + (size_t)l * DM * DM, DM, (bf16*)(wl + WL_WOUT), DM, kb, nb, 32 * nb, 32, scr, F.lane); }
}
__device__ __forceinline__ void p0_prologue(Frame& F) {
    fresh(F);
    LAS float* cact = (LAS float*)F.lds;
    LAS float* red = (LAS float*)(F.lds + 16384);
    for (int i = F.tid; i < 2 * DM; i += NTHR) { const float cv = F.in[I_C][i]; cact[i] = cv / (1.0f + expf(-cv)); }
    __syncthreads();
    float* MODS = (float*)(F.ws + WS_MODS);
    for (int it = blockIdx.x; it < 256; it += F.G) {
        const int l = it >> 6, cb = (it & 63) * 288;
        if (F.tid < 504) {
            const int cq = F.tid % 72, kg = F.tid / 72;
            const float* wp = F.in[I_MODW] + (size_t)l * DM * MODW + cb + 4 * cq;
            f32x4 a0 = {0.f, 0.f, 0.f, 0.f}, a1 = {0.f, 0.f, 0.f, 0.f};
#pragma unroll 8
            for (int k = kg; k < DM; k += 7) { const f32x4 w = *(const f32x4*)(wp + (size_t)k * MODW); a0 += cact[k] * w; a1 += cact[DM + k] * w; }
            *(LAS f32x4*)(red + (kg * 2 + 0) * 288 + 4 * cq) = a0; *(LAS f32x4*)(red + (kg * 2 + 1) * 288 + 4 * cq) = a1;
        }
        __syncthreads();
        for (int o = F.tid; o < 576; o += NTHR) { const int b = o / 288, col = o % 288; float s = F.in[I_MODB][l * MODW + cb + col];
#pragma unroll
            for (int kg = 0; kg < 7; ++kg) s += red[(kg * 2 + b) * 288 + col];
            MODS[(size_t)(l * 2 + b) * MODW + cb + col] = s; }
        __syncthreads();
    }
    const int gtid = F.vcu * NTHR + F.tid, NT = F.G * NTHR;
    f32x2v* ROPE = (f32x2v*)(F.ws + WS_ROPE);
    for (int idx = gtid; idx < SEQ * 64; idx += NT) { const int pos = idx >> 6, i = idx & 63;
        const float inv = (float)exp2(-(double)i * (13.287712379549449 / 64.0)); const float ang = (float)pos * inv; float s, c; sincosf(ang, &s, &c); ROPE[idx] = (f32x2v){c, s}; }
    LAS float* scr = (LAS float*)(F.lds + F.wave * 16384);
    const int gw = F.vcu * NWAVES + F.wave, NGW = F.G * NWAVES;
    for (int it = gw; it < IT_ALL; it += NGW) cvt_item(F, it, scr);
}

__device__ __forceinline__ void ph_modnorm(Frame& F, const float* xsrc, const float* nw, const float* mods_l, int jshift) {
    fresh(F);
    bf16* HN = (bf16*)(F.ws + WS_HN);
    const int gw = F.vcu * NWAVES + F.wave, NGW = F.G * NWAVES;
    for (int m = gw; m < MROWS; m += NGW) {
        const float* sh = mods_l + (size_t)(m >> 12) * MODW + jshift * DM; const float* sc = sh + DM;
        const GAS f32x4* xr = (const GAS f32x4*)(xsrc + (size_t)m * DM) + F.lane;
        f32x4 v[8]; float s = 0.f;
#pragma unroll
        for (int j = 0; j < 8; ++j) { v[j] = xr[64 * j]; s += (v[j].x * v[j].x + v[j].y * v[j].y) + (v[j].z * v[j].z + v[j].w * v[j].w); }
        const float rstd = 1.0f / sqrtf(wave_sum(s) * (1.0f / DM) + EPS);
#pragma unroll
        for (int j = 0; j < 8; ++j) { const int col = 4 * F.lane + 256 * j;
            const f32x4 w4 = *(const f32x4*)(nw + col), sc4 = *(const f32x4*)(sc + col), sh4 = *(const f32x4*)(sh + col);
            const f32x4 h = v[j] * rstd * w4 * (1.0f + sc4) + sh4;
            v2u o; o.x = pkbf(h.x, h.y); o.y = pkbf(h.z, h.w);
            *(GAS v2u*)(HN + (size_t)m * DM + col) = o; }
    }
}
__device__ __forceinline__ void ph_finalnorm(Frame& F) {
    fresh(F);
    const int gw = F.vcu * NWAVES + F.wave, NGW = F.G * NWAVES; const float* nw = F.in[I_FNW];
    for (int m = gw; m < MROWS; m += NGW) {
        GAS f32x4* xr = (GAS f32x4*)(F.out + (size_t)m * DM) + F.lane;
        f32x4 v[8]; float s = 0.f;
#pragma unroll
        for (int j = 0; j < 8; ++j) { v[j] = xr[64 * j]; s += (v[j].x * v[j].x + v[j].y * v[j].y) + (v[j].z * v[j].z + v[j].w * v[j].w); }
        const float rstd = 1.0f / sqrtf(wave_sum(s) * (1.0f / DM) + EPS);
#pragma unroll
        for (int j = 0; j < 8; ++j) { const f32x4 w4 = *(const f32x4*)(nw + 4 * F.lane + 256 * j); xr[64 * j] = v[j] * rstd * w4; }
    }
}
__device__ __forceinline__ void ph_pre(Frame& F, int l) {
    fresh(F);
    bf16* PROJ = (bf16*)(F.ws + WS_PROJ); bf16* XBCC = (bf16*)(F.ws + WS_XBCC);
    const int gtid = F.vcu * NTHR + F.tid, NT = F.G * NTHR;
    const float* cw = F.in[I_CONVW] + (size_t)l * 4 * NXBC; const float* cbv = F.in[I_CONVB] + (size_t)l * NXBC;
    for (int it = gtid; it < MROWS * (NXBC / 8); it += NT) {
        const int m = it / (NXBC / 8), cq = it % (NXBC / 8), ch0 = 8 * cq, tt = m & (SEQ - 1);
        float acc[8];
        { const f32x4 b0 = *(const f32x4*)(cbv + ch0), b1 = *(const f32x4*)(cbv + ch0 + 4); acc[0] = b0.x; acc[1] = b0.y; acc[2] = b0.z; acc[3] = b0.w; acc[4] = b1.x; acc[5] = b1.y; acc[6] = b1.z; acc[7] = b1.w; }
#pragma unroll
        for (int k = 0; k < 4; ++k) { if (tt - 3 + k >= 0) {
            const v4u raw = *(const GAS v4u*)(PROJ + (size_t)(m - 3 + k) * DINP + PX + ch0);
            const f32x4 w0 = *(const f32x4*)(cw + k * NXBC + ch0), w1 = *(const f32x4*)(cw + k * NXBC + ch0 + 4);
            acc[0] += w0.x * bflo(raw.x); acc[1] += w0.y * bfhi(raw.x); acc[2] += w0.z * bflo(raw.y); acc[3] += w0.w * bfhi(raw.y);
            acc[4] += w1.x * bflo(raw.z); acc[5] += w1.y * bfhi(raw.z); acc[6] += w1.z * bflo(raw.w); acc[7] += w1.w * bfhi(raw.w); } }
        v4u o; o.x = pkbf(silu(acc[0]), silu(acc[1])); o.y = pkbf(silu(acc[2]), silu(acc[3])); o.z = pkbf(silu(acc[4]), silu(acc[5])); o.w = pkbf(silu(acc[6]), silu(acc[7]));
        *(GAS v4u*)(XBCC + (size_t)m * NXBC + ch0) = o;
    }
    const float* ROPE = (const float*)(F.ws + WS_ROPE);
    for (int it = gtid; it < MROWS * 128; it += NT) {
        const int m = it >> 7, r = it & 127, which = r >> 6, h = (r >> 3) & 7, ic = r & 7, tt = m & (SEQ - 1);
        bf16* base = PROJ + (size_t)m * DINP + (which ? PK : PQ) + h * HDR + 8 * ic;
        const v4u x1 = *(const GAS v4u*)base, x2 = *(const GAS v4u*)(base + 64);
        const f32x4* cs = (const f32x4*)(ROPE + ((size_t)tt * 64 + 8 * ic) * 2);
        const float scl = which ? 0.08838834764831845f : 1.0f;
        unsigned o1[4], o2[4]; const unsigned xa[4] = {x1.x, x1.y, x1.z, x1.w}, xb[4] = {x2.x, x2.y, x2.z, x2.w};
#pragma unroll
        for (int e = 0; e < 4; ++e) { const f32x4 t = cs[e]; const float a0 = bflo(xa[e]), a1 = bfhi(xa[e]), b0 = bflo(xb[e]), b1 = bfhi(xb[e]);
            o1[e] = pkbf((a0 * t.x - b0 * t.y) * scl, (a1 * t.z - b1 * t.w) * scl); o2[e] = pkbf((a0 * t.y + b0 * t.x) * scl, (a1 * t.w + b1 * t.z) * scl); }
        *(GAS v4u*)base = (v4u){o1[0], o1[1], o1[2], o1[3]}; *(GAS v4u*)(base + 64) = (v4u){o2[0], o2[1], o2[2], o2[3]};
    }
    float* DTV = (float*)(F.ws + WS_DTV); float* ACUM = (float*)(F.ws + WS_ACUM);
    const int gw = F.vcu * NWAVES + F.wave, NGW = F.G * NWAVES;
    for (int ch = gw; ch < NCH; ch += NGW) {
        const int h = F.lane & 15, sub = F.lane >> 4, m0 = ch * CHUNK + sub * 32;
        const float A = -expf(F.in[I_ALOG][l * NHS + h]), bias = F.in[I_DTB][l * NHS + h];
        float cum = 0.f, dts[32], cs[32];
#pragma unroll
        for (int r = 0; r < 32; ++r) { const float x = bf1(PROJ[(size_t)(m0 + r) * DINP + PDT + h]) + bias; const float dt = x > 20.f ? x : log1pf(expf(x)); cum += dt * A; dts[r] = dt; cs[r] = cum; }
        const float t0 = __shfl(cum, h), t1 = __shfl(cum, h + 16), t2 = __shfl(cum, h + 32);
        const float off = (sub > 0 ? t0 : 0.f) + (sub > 1 ? t1 : 0.f) + (sub > 2 ? t2 : 0.f);
#pragma unroll
        for (int r = 0; r < 32; ++r) { DTV[(size_t)(m0 + r) * NHS + h] = dts[r]; ACUM[(size_t)(m0 + r) * NHS + h] = off + cs[r]; }
    }
}

constexpr int ST128 = 272, ST64 = 144;
__device__ __forceinline__ float ret_lg2(int h) { return log2f(1.0f - exp2f(-5.0f - (float)h)); }
__device__ __forceinline__ void ssd_states_item(Frame& F, int chunk, int g) {
    const bf16* XBCC = (const bf16*)(F.ws + WS_XBCC); const float* DTV = (const float*)(F.ws + WS_DTV); const float* ACUM = (const float*)(F.ws + WS_ACUM);
    float* SST = (float*)(F.ws + WS_SST);
    LAS unsigned char* Bs = F.lds; LAS unsigned char* XW = F.lds + 34816;
    const int m0 = chunk * CHUNK, q = F.lane >> 4, i = F.lane & 15;
    __syncthreads();
    for (int c = F.tid; c < 2048; c += NTHR) { const int row = c >> 4, cc = c & 15;
        *(LAS v4u*)(Bs + row * ST128 + cc * 16) = *(const GAS v4u*)(XBCC + (size_t)(m0 + row) * NXBC + DSSD + 128 * g + 8 * cc); }
    for (int hh = 0; hh < 8; ++hh) {
        const int h = 8 * g + hh; const float alast = ACUM[(size_t)(m0 + 127) * NHS + h];
        for (int c = F.tid; c < 1024; c += NTHR) { const int row = c >> 3, cc = c & 7;
            const float wl = DTV[(size_t)(m0 + row) * NHS + h] * fexp(alast - ACUM[(size_t)(m0 + row) * NHS + h]);
            const v4u raw = *(const GAS v4u*)(XBCC + (size_t)(m0 + row) * NXBC + HDS * h + 8 * cc);
            v4u o; o.x = pkbf(bflo(raw.x) * wl, bfhi(raw.x) * wl); o.y = pkbf(bflo(raw.y) * wl, bfhi(raw.y) * wl); o.z = pkbf(bflo(raw.z) * wl, bfhi(raw.z) * wl); o.w = pkbf(bflo(raw.w) * wl, bfhi(raw.w) * wl);
            *(LAS v4u*)(XW + row * ST64 + cc * 16) = o; }
        __syncthreads();
        const int rt = F.wave & 3, ct0 = 4 * (F.wave >> 2);
        f32x4 acc[4];
#pragma unroll
        for (int c4 = 0; c4 < 4; ++c4) acc[c4] = (f32x4){0.f, 0.f, 0.f, 0.f};
#pragma unroll
        for (int ks = 0; ks < 4; ++ks) { const bf16x8 a = frag_tr(XW, ST64, 32 * ks, 16 * rt, F.lane);
#pragma unroll
            for (int c4 = 0; c4 < 4; ++c4) { const bf16x8 b = frag_tr(Bs, ST128, 32 * ks, 16 * (ct0 + c4), F.lane); acc[c4] = MFMA16(a, b, acc[c4]); } }
        float* dst = SST + (size_t)(chunk * NHS + h) * HDS * NST;
#pragma unroll
        for (int c4 = 0; c4 < 4; ++c4)
#pragma unroll
            for (int reg = 0; reg < 4; ++reg) dst[(16 * rt + 4 * q + reg) * NST + 16 * (ct0 + c4) + i] = acc[c4][reg];
        __syncthreads();
    }
}
__device__ __forceinline__ void ret_kv_item(Frame& F, int item) {
    const bf16* PROJ = (const bf16*)(F.ws + WS_PROJ); float* KV = (float*)(F.ws + WS_KV);
    LAS unsigned char* KW = F.lds; LAS unsigned char* VS = F.lds + 34816;
    const int chunk = item >> 3, h = item & 7, m0 = chunk * CHUNK, q = F.lane >> 4, i = F.lane & 15;
    const float lg2 = ret_lg2(h);
    __syncthreads();
    for (int c = F.tid; c < 2048; c += NTHR) { const int row = c >> 4, cc = c & 15; const float kd = __builtin_amdgcn_exp2f((float)(127 - row) * lg2);
        const v4u raw = *(const GAS v4u*)(PROJ + (size_t)(m0 + row) * DINP + PK + HDR * h + 8 * cc);
        v4u o; o.x = pkbf(bflo(raw.x) * kd, bfhi(raw.x) * kd); o.y = pkbf(bflo(raw.y) * kd, bfhi(raw.y) * kd); o.z = pkbf(bflo(raw.z) * kd, bfhi(raw.z) * kd); o.w = pkbf(bflo(raw.w) * kd, bfhi(raw.w) * kd);
        *(LAS v4u*)(KW + row * ST128 + cc * 16) = o;
        *(LAS v4u*)(VS + row * ST128 + cc * 16) = *(const GAS v4u*)(PROJ + (size_t)(m0 + row) * DINP + PV + HDR * h + 8 * cc); }
    __syncthreads();
    f32x4 acc[8];
#pragma unroll
    for (int et = 0; et < 8; ++et) acc[et] = (f32x4){0.f, 0.f, 0.f, 0.f};
#pragma unroll
    for (int ks = 0; ks < 4; ++ks) { const bf16x8 a = frag_tr(KW, ST128, 32 * ks, 16 * F.wave, F.lane);
#pragma unroll
        for (int et = 0; et < 8; ++et) { const bf16x8 b = frag_tr(VS, ST128, 32 * ks, 16 * et, F.lane); acc[et] = MFMA16(a, b, acc[et]); } }
    float* dst = KV + (size_t)(chunk * NHR + h) * HDR * HDR;
#pragma unroll
    for (int et = 0; et < 8; ++et)
#pragma unroll
        for (int reg = 0; reg < 4; ++reg) dst[(16 * F.wave + 4 * q + reg) * HDR + 16 * et + i] = acc[et][reg];
}
__device__ __forceinline__ void ph_states(Frame& F) {
    fresh(F);
    for (int v = blockIdx.x; v < 256; v += F.G) {
        if (v < 128) ssd_states_item(F, v >> 1, v & 1);
        else for (int k = 0; k < 4; ++k) ret_kv_item(F, (v - 128) * 4 + k);
    }
}
__device__ __forceinline__ void ph_scan(Frame& F) {
    fresh(F);
    const float* ACUM = (const float*)(F.ws + WS_ACUM);
    const int gtid = F.vcu * NTHR + F.tid, NT = F.G * NTHR;
    for (int s = gtid; s < 131072; s += NT) {
        const bool ssd = s < 65536; const int s2 = s & 65535, b = s2 >> 15;
        const int h = ssd ? (s2 >> 11) & 15 : (s2 >> 12) & 7, idx = ssd ? (s2 & 2047) : (s2 & 4095);
        const int nh = ssd ? NHS : NHR, per = ssd ? 2048 : 4096;
        const f32x4* src = (const f32x4*)(F.ws + (ssd ? WS_SST : WS_KV)); f32x4* dst = (f32x4*)(F.ws + (ssd ? WS_SSTP : WS_KVP));
        const float dret = __builtin_amdgcn_exp2f(128.0f * ret_lg2(h));
        f32x4 carry = {0.f, 0.f, 0.f, 0.f};
        for (int c0 = 0; c0 < 32; c0 += 8) {
            f32x4 sv[8]; float dv[8];
#pragma unroll
            for (int k = 0; k < 8; ++k) { const int cg = b * 32 + c0 + k; sv[k] = src[(size_t)(cg * nh + h) * per + idx]; dv[k] = ssd ? fexp(ACUM[(size_t)(cg * CHUNK + 127) * NHS + h]) : dret; }
#pragma unroll
            for (int k = 0; k < 8; ++k) { const int cg = b * 32 + c0 + k; dst[(size_t)(cg * nh + h) * per + idx] = carry; carry = carry * dv[k] + sv[k]; }
        }
    }
}
__device__ __forceinline__ unsigned short bf16_of(float v) { return (unsigned short)(pkbf(v, 0.f) & 0xffffu); }
__device__ __forceinline__ void ssd_out_item(Frame& F, int l, int chunk, int g) {
    const bf16* XBCC = (const bf16*)(F.ws + WS_XBCC); const bf16* PROJ = (const bf16*)(F.ws + WS_PROJ);
    const float* DTV = (const float*)(F.ws + WS_DTV); const float* ACUM = (const float*)(F.ws + WS_ACUM); const float* SSTP = (const float*)(F.ws + WS_SSTP);
    bf16* YMIX = (bf16*)(F.ws + WS_YMIX); float* SSQ = (float*)(F.ws + WS_SSQ);
    LAS unsigned char* Cs = F.lds; LAS unsigned char* Bs = F.lds + 34816; LAS unsigned char* PVs = Bs;
    LAS unsigned char* GW = F.lds + 69632 + F.wave * (16 * ST128); LAS unsigned char* XS = F.lds + 104448;
    LAS float* AC = (LAS float*)(F.lds + 122880); LAS float* DTs = AC + 128;
    const int m0 = chunk * CHUNK, q = F.lane >> 4, i = F.lane & 15, w = F.wave;
    __syncthreads();
    for (int c = F.tid; c < 2048; c += NTHR) { const int row = c >> 4, cc = c & 15;
        *(LAS v4u*)(Bs + row * ST128 + cc * 16) = *(const GAS v4u*)(XBCC + (size_t)(m0 + row) * NXBC + DSSD + 128 * g + 8 * cc);
        *(LAS v4u*)(Cs + row * ST128 + cc * 16) = *(const GAS v4u*)(XBCC + (size_t)(m0 + row) * NXBC + DSSD + 256 + 128 * g + 8 * cc); }
    for (int c = F.lane; c < 16 * ST128 / 16; c += 64) *(LAS v4u*)(GW + c * 16) = (v4u){0u, 0u, 0u, 0u};
    __syncthreads();
    bf16x8 cfrag[4];
#pragma unroll
    for (int ks = 0; ks < 4; ++ks) cfrag[ks] = frag_row(Cs, ST128, 16 * w, 32 * ks, F.lane);
    f32x4 cbT[8];
#pragma unroll
    for (int st = 0; st < 8; ++st) { cbT[st] = (f32x4){0.f, 0.f, 0.f, 0.f};
        if (st <= w) {
#pragma unroll
            for (int ks = 0; ks < 4; ++ks) { const bf16x8 a = frag_row(Bs, ST128, 16 * st, 32 * ks, F.lane); cbT[st] = MFMA16(a, cfrag[ks], cbT[st]); } } }
    __syncthreads();
    for (int hh = 0; hh < 8; ++hh) {
        const int h = 8 * g + hh;
        for (int c = F.tid; c < 1024; c += NTHR) { const int row = c >> 3, cc = c & 7;
            *(LAS v4u*)(XS + row * ST64 + cc * 16) = *(const GAS v4u*)(XBCC + (size_t)(m0 + row) * NXBC + HDS * h + 8 * cc); }
        { const f32x4* src = (const f32x4*)(SSTP + (size_t)(chunk * NHS + h) * HDS * NST);
          for (int c = F.tid; c < 2048; c += NTHR) { const int p = c >> 5, n4 = c & 31; const f32x4 v = src[c]; v2u o; o.x = pkbf(v.x, v.y); o.y = pkbf(v.z, v.w); *(LAS v2u*)(PVs + p * ST128 + n4 * 8) = o; } }
        if (F.tid < 128) { AC[F.tid] = ACUM[(size_t)(m0 + F.tid) * NHS + h]; DTs[F.tid] = DTV[(size_t)(m0 + F.tid) * NHS + h]; }
        __syncthreads();
        const float al = AC[16 * w + i];
#pragma unroll
        for (int st = 0; st < 8; ++st) { if (st <= w) {
            const f32x4 as4 = *(const LAS f32x4*)(AC + 16 * st + 4 * q), dt4 = *(const LAS f32x4*)(DTs + 16 * st + 4 * q);
            float val[4];
#pragma unroll
            for (int reg = 0; reg < 4; ++reg) { const int s = 16 * st + 4 * q + reg, lr = 16 * w + i; const float x = cbT[st][reg] * fexp(al - as4[reg]) * dt4[reg]; val[reg] = (s <= lr) ? x : 0.f; }
            v2u o; o.x = pkbf(val[0], val[1]); o.y = pkbf(val[2], val[3]);
            *(LAS v2u*)(GW + i * ST128 + (16 * st + 4 * q) * 2) = o; } }
        LDS_WAIT(); asm volatile("" ::: "memory");
        f32x4 y[4];
#pragma unroll
        for (int pt = 0; pt < 4; ++pt) y[pt] = (f32x4){0.f, 0.f, 0.f, 0.f};
#pragma unroll
        for (int ks = 0; ks < 4; ++ks)
#pragma unroll
            for (int pt = 0; pt < 4; ++pt) { const bf16x8 b = frag_row(PVs, ST128, 16 * pt, 32 * ks, F.lane); y[pt] = MFMA16(cfrag[ks], b, y[pt]); }
        { const f32x4 a4 = *(const LAS f32x4*)(AC + 16 * w + 4 * q); const f32x4 ea = {fexp(a4.x), fexp(a4.y), fexp(a4.z), fexp(a4.w)};
#pragma unroll
          for (int pt = 0; pt < 4; ++pt) y[pt] = y[pt] * ea; }
#pragma unroll
        for (int ks = 0; ks < 4; ++ks) { if (ks <= (w >> 1)) { const bf16x8 a = frag_row(GW, ST128, 0, 32 * ks, F.lane);
#pragma unroll
            for (int pt = 0; pt < 4; ++pt) { const bf16x8 b = frag_tr(XS, ST64, 32 * ks, 16 * pt, F.lane); y[pt] = MFMA16(a, b, y[pt]); } } }
        const float Dh = F.in[I_DSKIP][l * NHS + h];
        float ssq[4] = {0.f, 0.f, 0.f, 0.f};
#pragma unroll
        for (int pt = 0; pt < 4; ++pt)
#pragma unroll
            for (int reg = 0; reg < 4; ++reg) { const int lr = 16 * w + 4 * q + reg, p = 16 * pt + i;
                const float xv = bf1(*(const LAS bf16*)(XS + lr * ST64 + p * 2)), zv = bf1(PROJ[(size_t)(m0 + lr) * DINP + PZ + HDS * h + p]);
                const float v = (y[pt][reg] + xv * Dh) * silu(zv);
                YMIX[(size_t)(m0 + lr) * DM + HDS * h + p] = bf16_of(v); ssq[reg] += v * v; }
#pragma unroll
        for (int reg = 0; reg < 4; ++reg) { const float s = sum16(ssq[reg]); if (i == 0) SSQ[(size_t)(m0 + 16 * w + 4 * q + reg) * NHS + h] = s; }
        __syncthreads();
    }
}
__device__ __forceinline__ void ret_out_item(Frame& F, int l, int item) {
    const bf16* PROJ = (const bf16*)(F.ws + WS_PROJ); const float* KVP = (const float*)(F.ws + WS_KVP); bf16* YMIX = (bf16*)(F.ws + WS_YMIX);
    LAS unsigned char* Qs = F.lds; LAS unsigned char* Ks = F.lds + 34816; LAS unsigned char* PVs = Ks; LAS unsigned char* Vs = F.lds + 69632;
    LAS unsigned char* PW = F.lds + 104448 + F.wave * (16 * ST128);
    const int chunk = item >> 3, h = item & 7, m0 = chunk * CHUNK, q = F.lane >> 4, i = F.lane & 15, w = F.wave;
    const float lg2 = ret_lg2(h);
    __syncthreads();
    for (int c = F.tid; c < 2048; c += NTHR) { const int row = c >> 4, cc = c & 15; const bf16* src = PROJ + (size_t)(m0 + row) * DINP + HDR * h + 8 * cc;
        *(LAS v4u*)(Qs + row * ST128 + cc * 16) = *(const GAS v4u*)(src + PQ);
        *(LAS v4u*)(Ks + row * ST128 + cc * 16) = *(const GAS v4u*)(src + PK);
        *(LAS v4u*)(Vs + row * ST128 + cc * 16) = *(const GAS v4u*)(src + PV); }
    for (int c = F.lane; c < 16 * ST128 / 16; c += 64) *(LAS v4u*)(PW + c * 16) = (v4u){0u, 0u, 0u, 0u};
    __syncthreads();
    bf16x8 qfrag[4];
#pragma unroll
    for (int ks = 0; ks < 4; ++ks) qfrag[ks] = frag_row(Qs, ST128, 16 * w, 32 * ks, F.lane);
#pragma unroll
    for (int st = 0; st < 8; ++st) { if (st <= w) {
        f32x4 sT = {0.f, 0.f, 0.f, 0.f};
#pragma unroll
        for (int ks = 0; ks < 4; ++ks) { const bf16x8 a = frag_row(Ks, ST128, 16 * st, 32 * ks, F.lane); sT = MFMA16(a, qfrag[ks], sT); }
        float val[4];
#pragma unroll
        for (int reg = 0; reg < 4; ++reg) { const int d = 16 * w + i - (16 * st + 4 * q + reg); const float x = sT[reg] * __builtin_amdgcn_exp2f((float)d * lg2); val[reg] = (d >= 0) ? x : 0.f; }
        v2u o; o.x = pkbf(val[0], val[1]); o.y = pkbf(val[2], val[3]);
        *(LAS v2u*)(PW + i * ST128 + (16 * st + 4 * q) * 2) = o; } }
    __syncthreads();
    { const f32x4* src = (const f32x4*)(KVP + (size_t)(chunk * NHR + h) * HDR * HDR);
      for (int c = F.tid; c < 4096; c += NTHR) { const int d = c >> 5, e4 = c & 31; const f32x4 v = src[c]; v2u o; o.x = pkbf(v.x, v.y); o.y = pkbf(v.z, v.w); *(LAS v2u*)(PVs + d * ST128 + e4 * 8) = o; } }
    __syncthreads();
    f32x4 o[8];
#pragma unroll
    for (int et = 0; et < 8; ++et) o[et] = (f32x4){0.f, 0.f, 0.f, 0.f};
#pragma unroll
    for (int ks = 0; ks < 4; ++ks)
#pragma unroll
        for (int et = 0; et < 8; ++et) { const bf16x8 b = frag_tr(PVs, ST128, 32 * ks, 16 * et, F.lane); o[et] = MFMA16(qfrag[ks], b, o[et]); }
    { f32x4 qd;
#pragma unroll
      for (int reg = 0; reg < 4; ++reg) qd[reg] = __builtin_amdgcn_exp2f((float)(16 * w + 4 * q + reg + 1) * lg2);
#pragma unroll
      for (int et = 0; et < 8; ++et) o[et] = o[et] * qd; }
#pragma unroll
    for (int ks = 0; ks < 4; ++ks) { if (ks <= (w >> 1)) { const bf16x8 a = frag_row(PW, ST128, 0, 32 * ks, F.lane);
#pragma unroll
        for (int et = 0; et < 8; ++et) { const bf16x8 b = frag_tr(Vs, ST128, 32 * ks, 16 * et, F.lane); o[et] = MFMA16(a, b, o[et]); } } }
    const float* gnw = F.in[I_RETNW] + (size_t)l * DSSD + HDR * h; const float* gnb = F.in[I_RETNB] + (size_t)l * DSSD + HDR * h;
#pragma unroll
    for (int reg = 0; reg < 4; ++reg) {
        float s = 0.f;
#pragma unroll
        for (int et = 0; et < 8; ++et) s += o[et][reg];
        const float mu = sum16(s) * (1.0f / HDR); float vs = 0.f;
#pragma unroll
        for (int et = 0; et < 8; ++et) { const float d = o[et][reg] - mu; vs += d * d; }
        const float rstd = 1.0f / sqrtf(sum16(vs) * (1.0f / HDR) + EPS);
        const int lr = 16 * w + 4 * q + reg;
#pragma unroll
        for (int et = 0; et < 8; ++et) { const int e = 16 * et + i; const float on = (o[et][reg] - mu) * rstd * gnw[e] + gnb[e];
            const float gt = bf1(PROJ[(size_t)(m0 + lr) * DINP + PG + HDR * h + e]);
            YMIX[(size_t)(m0 + lr) * DM + DSSD + HDR * h + e] = bf16_of(silu(gt) * on); }
    }
}
__device__ __forceinline__ void ph_outputs(Frame& F, int l) {
    fresh(F);
    for (int v = blockIdx.x; v < 256; v += F.G) {
        if (v < 128) ssd_out_item(F, l, v >> 1, v & 1);
        else for (int k = 0; k < 4; ++k) ret_out_item(F, l, (v - 128) * 4 + k);
    }
}
__device__ __forceinline__ void ph_finalize(Frame& F, int l) {
    fresh(F);
    bf16* YMIX = (bf16*)(F.ws + WS_YMIX); const float* SSQ = (const float*)(F.ws + WS_SSQ); const float* nw = F.in[I_SSDNW] + (size_t)l * DSSD;
    const int gtid = F.vcu * NTHR + F.tid, NT = F.G * NTHR;
    for (int it = gtid; it < MROWS * 128; it += NT) { const int m = it >> 7, cq = it & 127;
        const f32x4* sq = (const f32x4*)(SSQ + (size_t)m * NHS); const f32x4 s0 = sq[0], s1 = sq[1], s2 = sq[2], s3 = sq[3];
        const float tot = ((s0.x + s0.y) + (s0.z + s0.w)) + ((s1.x + s1.y) + (s1.z + s1.w)) + ((s2.x + s2.y) + (s2.z + s2.w)) + ((s3.x + s3.y) + (s3.z + s3.w));
        const float r = 1.0f / sqrtf(tot * (1.0f / DSSD) + EPS);
        GAS v4u* p = (GAS v4u*)(YMIX + (size_t)m * DM + 8 * cq); const v4u raw = *p;
        const f32x4 w0 = *(const f32x4*)(nw + 8 * cq) * r, w1 = *(const f32x4*)(nw + 8 * cq + 4) * r;
        v4u o; o.x = pkbf(bflo(raw.x) * w0.x, bfhi(raw.x) * w0.y); o.y = pkbf(bflo(raw.y) * w0.z, bfhi(raw.y) * w0.w); o.z = pkbf(bflo(raw.z) * w1.x, bfhi(raw.z) * w1.y); o.w = pkbf(bflo(raw.w) * w1.z, bfhi(raw.w) * w1.w);
        *p = o; }
}

constexpr int PH_PER_LAYER = 14, NPH = 2 + DEPTH * PH_PER_LAYER;
struct Args { const float* in[18]; float* out; unsigned char* ws; int ph_lo, ph_hi; };
__global__ void __launch_bounds__(NTHR, 2) mk_fwd(Args args) {
    extern __shared__ __attribute__((aligned(16))) unsigned char lds[];
    Frame F;
    F.lds = (LAS unsigned char*)lds;
    F.tid = threadIdx.x; F.lane = F.tid & 63; F.wave = __builtin_amdgcn_readfirstlane(F.tid >> 6);
    F.G = gridDim.x; { const int bx = blockIdx.x; F.vcu = (F.G % 8 == 0) ? (bx % 8) * (F.G / 8) + bx / 8 : bx; }
    F.ws = args.ws; F.out = args.out;
#pragma unroll
    for (int k = 0; k < 18; ++k) F.in[k] = args.in[k];
    volatile LAS unsigned* MISC = (volatile LAS unsigned*)(F.lds + MISC_OFF);
    for (int u = F.tid; u < (LDS_BYTES - MISC_OFF) / 4; u += NTHR) MISC[u] = 0u;
    __syncthreads();
    const int lo = args.ph_lo, hi = args.ph_hi;
    XcdBarrier bar; bar.bar = (unsigned*)(F.ws + WS_CTL) + CW_BAR; bar.x = 0; bar.st = nullptr;
    if (hi - lo > 1) bar = xcd_barrier_post((unsigned*)(F.ws + WS_CTL) + CW_BAR, MISC + 8);
#define IN(k) (lo <= (k) && (k) < hi)
#define SEAM(k) do { if (IN((k) + 1)) xcd_barrier(bar); } while (0)
    if (IN(0)) { p0_prologue(F); SEAM(0); }
    const float* MODS = (const float*)(F.ws + WS_MODS);
    for (int l = 0; l < DEPTH; ++l) {
        const int pb = 1 + PH_PER_LAYER * l;
        if (pb + PH_PER_LAYER <= lo || pb >= hi) continue;
        const float* mods_l = MODS + (size_t)l * 2 * MODW;
        unsigned char* wl = F.ws + WS_W + (size_t)l * WL_BYTES;
        const float* nw = F.in[I_NORMW] + (size_t)l * 3 * DM;
        const float* xin0 = (l == 0) ? F.in[I_X] : F.out;
        if (IN(pb + 0)) { ph_modnorm(F, xin0, nw, mods_l, 0); SEAM(pb + 0); }
        if (IN(pb + 1)) { pg8::Gemm g{(const bf16*)(F.ws + WS_HN), (const bf16*)(wl + WL_W13), MROWS, DFF2, DM}; pg8::StaticOrder S; S.init(MROWS, DFF2, F.G, (int)blockIdx.x);
            pg8::EpiSwiGLU E{(bf16*)(F.ws + WS_H1), DFF}; pg8::gemm_phase<pg8::EpiSwiGLU, pg8::StaticOrder, true, true>(F.lds, g, S, E); SEAM(pb + 1); }
        if (IN(pb + 2)) { pg8::Gemm g{(const bf16*)(F.ws + WS_H1), (const bf16*)(wl + WL_W2), MROWS, DM, DFF}; pg8::StaticOrder S; S.init(MROWS, DM, F.G, (int)blockIdx.x);
            pg8::EpiResid E{xin0, F.out, DM, mods_l + 2 * DM, MODW, SEQ, 0.5f}; pg8::gemm_phase<pg8::EpiResid, pg8::StaticOrder, true, true>(F.lds, g, S, E); SEAM(pb + 2); }
        if (IN(pb + 3)) { ph_modnorm(F, F.out, nw + DM, mods_l, 3); SEAM(pb + 3); }
        if (IN(pb + 4)) { pg8::Gemm g{(const bf16*)(F.ws + WS_HN), (const bf16*)(wl + WL_WIN), MROWS, DINP, DM}; pg8::StaticOrder S; S.init(MROWS, DINP, F.G, (int)blockIdx.x);
            pg8::EpiBf16 E{(bf16*)(F.ws + WS_PROJ), DINP}; pg8::gemm_phase<pg8::EpiBf16, pg8::StaticOrder, true, true>(F.lds, g, S, E); SEAM(pb + 4); }
        if (IN(pb + 5)) { ph_pre(F, l); SEAM(pb + 5); }
        if (IN(pb + 6)) { ph_states(F); SEAM(pb + 6); }
        if (IN(pb + 7)) { ph_scan(F); SEAM(pb + 7); }
        if (IN(pb + 8)) { ph_outputs(F, l); SEAM(pb + 8); }
        if (IN(pb + 9)) { ph_finalize(F, l); SEAM(pb + 9); }
        if (IN(pb + 10)) { pg8::Gemm g{(const bf16*)(F.ws + WS_YMIX), (const bf16*)(wl + WL_WOUT), MROWS, DM, DM}; pg8::StaticOrder S; S.init(MROWS, DM, F.G, (int)blockIdx.x);
            pg8::EpiResid E{F.out, F.out, DM, mods_l + 5 * DM, MODW, SEQ, 1.0f}; pg8::gemm_phase<pg8::EpiResid, pg8::StaticOrder, true, true>(F.lds, g, S, E); SEAM(pb + 10); }
        if (IN(pb + 11)) { ph_modnorm(F, F.out, nw + 2 * DM, mods_l, 6); SEAM(pb + 11); }
        if (IN(pb + 12)) { pg8::Gemm g{(const bf16*)(F.ws + WS_HN), (const bf16*)(wl + WL_W13 + W13_BYTES), MROWS, DFF2, DM}; pg8::StaticOrder S; S.init(MROWS, DFF2, F.G, (int)blockIdx.x);
            pg8::EpiSwiGLU E{(bf16*)(F.ws + WS_H1), DFF}; pg8::gemm_phase<pg8::EpiSwiGLU, pg8::StaticOrder, true, true>(F.lds, g, S, E); SEAM(pb + 12); }
        if (IN(pb + 13)) { pg8::Gemm g{(const bf16*)(F.ws + WS_H1), (const bf16*)(wl + WL_W2 + W2_BYTES), MROWS, DM, DFF}; pg8::StaticOrder S; S.init(MROWS, DM, F.G, (int)blockIdx.x);
            pg8::EpiResid E{F.out, F.out, DM, mods_l + 8 * DM, MODW, SEQ, 0.5f}; pg8::gemm_phase<pg8::EpiResid, pg8::StaticOrder, true, true>(F.lds, g, S, E); SEAM(pb + 13); }
    }
    if (IN(NPH - 1)) ph_finalnorm(F);
#undef IN
#undef SEAM
}

#ifndef MK_PER_PHASE
#define MK_PER_PHASE 0
#endif
extern "C" void kernel_launch(void* const* d_in, const int* in_sizes, int n_in, void* d_out, int out_size, void* d_ws, size_t ws_size, hipStream_t stream) {
    static int grid = 0;
    if (grid == 0) {
        if (n_in != 18 || out_size != MROWS * DM || ws_size < WS_END) { fprintf(stderr, "kernel_launch: unexpected shapes (n_in %d out %d ws %zu need %zu)\n", n_in, out_size, ws_size, (size_t)WS_END); grid = -1; return; }
        int dev = 0, cus = 0, per_cu = 0;
        if (hipGetDevice(&dev) != hipSuccess || hipDeviceGetAttribute(&cus, hipDeviceAttributeMultiprocessorCount, dev) != hipSuccess) { grid = -1; return; }
        if (hipFuncSetAttribute((const void*)mk_fwd, hipFuncAttributeMaxDynamicSharedMemorySize, LDS_BYTES) != hipSuccess) { fprintf(stderr, "kernel_launch: hipFuncSetAttribute failed\n"); grid = -1; return; }
        if (hipOccupancyMaxActiveBlocksPerMultiprocessor(&per_cu, (const void*)mk_fwd, NTHR, LDS_BYTES) != hipSuccess || per_cu < 1) fprintf(stderr, "kernel_launch: occupancy query says %d\n", per_cu);
        (void)hipGetLastError();
        grid = cus;
    }
    if (grid < 0) return;
    (void)in_sizes;
    if (hipMemsetAsync((char*)d_ws + WS_CTL, 0, CTL_ZERO_BYTES, stream) != hipSuccess) return;
    Args a{};
    for (int i = 0; i < 18; ++i) a.in[i] = (const float*)d_in[i];
    a.out = (float*)d_out; a.ws = (unsigned char*)d_ws;
#if MK_PER_PHASE
    for (int p = 0; p < NPH; ++p) { a.ph_lo = p; a.ph_hi = p + 1; hipLaunchKernelGGL(mk_fwd, dim3(grid), dim3(NTHR), LDS_BYTES, stream, a); }
#else
    a.ph_lo = 0; a.ph_hi = NPH;
    hipLaunchKernelGGL(mk_fwd, dim3(grid), dim3(NTHR), LDS_BYTES, stream, a);
#endif
}
```

```cpp
#include <hip/hip_runtime.h>
#include <cstdio>
#include <cstdint>
namespace pg8 {
#define PG8_LAS __attribute__((address_space(3)))
typedef unsigned short bf16_t;
typedef short bf16x8 __attribute__((ext_vector_type(8)));
typedef float f32x4 __attribute__((ext_vector_type(4)));
typedef unsigned u32x4 __attribute__((ext_vector_type(4)));
constexpr int BM = 256, BK = 64, HALF = 128, HTB = HALF * BK * 2  , STAGE_BYTES = 8 * HTB, NXCD = 8, WGM = 8;

__host__ __device__ __forceinline__ int lds_byte(int r, int c) { const int st = (r >> 4) * 2 + (c >> 5), rr = r & 15, cc = c & 31, ob = rr * 64 + cc * 2; return st * 1024 + (ob ^ (((ob >> 9) & 1) << 5)); }
__host__ __device__ __forceinline__ void stage_rc(int b, int& R, int& C) { const int st = b / 1024, sb = b % 1024, swz = sb ^ (((sb >> 9) & 1) << 5); R = (st >> 1) * 16 + swz / 64; C = (st & 1) * 32 + (swz % 64) / 2; }
__host__ __device__ __forceinline__ int perm32(int rho) { const int n = rho >> 4, i = rho & 15; return 8 * (i >> 2) + 4 * n + (i & 3); }

struct Unit { int pm, pn; };
struct Gemm { const bf16_t* A; const bf16_t* Bt; int M, N, K; };

struct StaticOrder {
    int nM, nN, nwg, G, c;
    __host__ __device__ void init(int M, int N, int G_, int c_) { nM = M / BM; nN = N / BM; nwg = nM * nN; G = G_; c = c_; }
    __host__ __device__ bool next(int i, Unit& u) const {
        const long L = (long)i * G + c; if (L >= nwg) return false;
        int wgid = (int)L; { const int q = nwg / NXCD, r = nwg % NXCD, xcd = wgid % NXCD, off = wgid / NXCD; wgid = (xcd < r ? xcd * (q + 1) : r * (q + 1) + (xcd - r) * q) + off; }
        const int nig = WGM * nN, gid = wgid / nig, fm = gid * WGM, gsz = (nM - fm) < WGM ? (nM - fm) : WGM;
        u.pm = fm + ((wgid % nig) % gsz); u.pn = (wgid % nig) / gsz; return true;
    }
    __device__ __forceinline__ void a_ready(const Unit&) const {}
    __device__ __forceinline__ void done(const Unit&) const {}
};
__device__ __forceinline__ unsigned cvt_pk_bf16(float lo, float hi) { unsigned r; asm volatile("v_cvt_pk_bf16_f32 %0, %1, %2" : "=v"(r) : "v"(lo), "v"(hi)); return r; }
typedef float f32x2 __attribute__((ext_vector_type(2)));
typedef float f32x2 __attribute__((ext_vector_type(2)));
__device__ __forceinline__ float silu_f(float a) { return a * __builtin_amdgcn_rcpf(1.0f + __builtin_amdgcn_exp2f(-1.4426950408889634f * a)); }

struct EpiBf16 {
    static constexpr bool PERM = true, AFTER_DRAIN = false;
    bf16_t* O; int ldc;
    __device__ __forceinline__ void operator()(const f32x4 (&acc)[2][2][4][2], const Unit& u, int wr, int wc, int fr, int fq) const {
        const int row0 = u.pm * BM + wr * 64 + fr, col0 = u.pn * BM + wc * 32 + 8 * fq;
#pragma unroll
        for (int ai = 0; ai < 2; ++ai)
#pragma unroll
            for (int m = 0; m < 4; ++m) { bf16_t* rowp = O + (size_t)(row0 + ai * HALF + m * 16) * ldc + col0;
#pragma unroll
                for (int bj = 0; bj < 2; ++bj) { const f32x4 v0 = acc[ai][bj][m][0], v1 = acc[ai][bj][m][1];
                    u32x4 w; w.x = cvt_pk_bf16(v0[0], v0[1]); w.y = cvt_pk_bf16(v0[2], v0[3]); w.z = cvt_pk_bf16(v1[0], v1[1]); w.w = cvt_pk_bf16(v1[2], v1[3]);
                    *(u32x4*)(rowp + bj * HALF) = w; } }
    }
};
struct EpiSwiGLU {
    static constexpr bool PERM = true, AFTER_DRAIN = false;
    bf16_t* O; int ldc;
    __device__ __forceinline__ void operator()(const f32x4 (&acc)[2][2][4][2], const Unit& u, int wr, int wc, int fr, int fq) const {
        const int row0 = u.pm * BM + wr * 64 + fr, col0 = u.pn * HALF + wc * 32 + 8 * fq;
#pragma unroll
        for (int ai = 0; ai < 2; ++ai)
#pragma unroll
            for (int m = 0; m < 4; ++m) { bf16_t* rowp = O + (size_t)(row0 + ai * HALF + m * 16) * ldc + col0;
                const f32x4 a0 = acc[ai][0][m][0], a1 = acc[ai][0][m][1], b0 = acc[ai][1][m][0], b1 = acc[ai][1][m][1];
                u32x4 w;
                w.x = cvt_pk_bf16(silu_f(a0[0]) * b0[0], silu_f(a0[1]) * b0[1]); w.y = cvt_pk_bf16(silu_f(a0[2]) * b0[2], silu_f(a0[3]) * b0[3]);
                w.z = cvt_pk_bf16(silu_f(a1[0]) * b1[0], silu_f(a1[1]) * b1[1]); w.w = cvt_pk_bf16(silu_f(a1[2]) * b1[2], silu_f(a1[3]) * b1[3]);
                *(u32x4*)rowp = w; }
    }
};
struct EpiResid {
    static constexpr bool PERM = false, AFTER_DRAIN = false;
    const float* xin; float* xout; int ldc; const float* gate; int gstride; int rows_per_batch; float gs;
    __device__ __forceinline__ void operator()(const f32x4 (&acc)[2][2][4][2], const Unit& u, int wr, int wc, int fr, int fq) const {
        const int row0 = u.pm * BM + wr * 64 + fr, col0 = u.pn * BM + wc * 32 + 4 * fq;
        const float* g = gate + (size_t)((u.pm * BM) / rows_per_batch) * gstride;
        f32x4 gv[2][2];
#pragma unroll
        for (int bj = 0; bj < 2; ++bj)
#pragma unroll
            for (int n = 0; n < 2; ++n) gv[bj][n] = *(const f32x4*)(g + col0 + bj * HALF + n * 16) * gs;
#pragma unroll
        for (int ai = 0; ai < 2; ++ai)
#pragma unroll
            for (int m = 0; m < 4; ++m) { const size_t off = (size_t)(row0 + ai * HALF + m * 16) * ldc + col0;
#pragma unroll
                for (int bj = 0; bj < 2; ++bj)
#pragma unroll
                    for (int n = 0; n < 2; ++n) { const f32x4 xv = *(const f32x4*)(xin + off + bj * HALF + n * 16);
                        *(f32x4*)(xout + off + bj * HALF + n * 16) = xv + gv[bj][n] * acc[ai][bj][m][n]; } }
    }
};

struct EpiInProj {
    static constexpr bool PERM = true, AFTER_DRAIN = false;
    bf16_t* O; int ldc; const float* rope; float* dtr; int qcol, kcol, seqmask;
    __device__ __forceinline__ void operator()(const f32x4 (&acc)[2][2][4][2], const Unit& u, int wr, int wc, int fr, int fq) const {
        const int row0 = u.pm * BM + wr * 64 + fr;
        if (u.pn >= 10 && u.pn < 18) {
            const bool isk = u.pn >= 14; const float scl = isk ? 0.08838834764831845f : 1.0f;
            const int T = (u.pn - 10) & 3, cl = wc * 32 + 8 * fq, hh = cl >> 6, i0 = cl & 63;
            const int colbase = (isk ? kcol : qcol) + (2 * T + hh) * 128 + i0;
#pragma unroll
            for (int ai = 0; ai < 2; ++ai)
#pragma unroll
                for (int m = 0; m < 4; ++m) { const int r = row0 + ai * HALF + m * 16, tt = r & seqmask;
                    const f32x4* cs = (const f32x4*)(rope + ((size_t)tt * 64 + i0) * 2);
                    const f32x4 t0 = cs[0], t1 = cs[1], t2 = cs[2], t3 = cs[3];
                    const f32x4 a0 = acc[ai][0][m][0], a1 = acc[ai][0][m][1], b0 = acc[ai][1][m][0], b1 = acc[ai][1][m][1];
                    u32x4 w1, w2;
                    w1.x = cvt_pk_bf16((a0[0] * t0.x - b0[0] * t0.y) * scl, (a0[1] * t0.z - b0[1] * t0.w) * scl); w2.x = cvt_pk_bf16((a0[0] * t0.y + b0[0] * t0.x) * scl, (a0[1] * t0.w + b0[1] * t0.z) * scl);
                    w1.y = cvt_pk_bf16((a0[2] * t1.x - b0[2] * t1.y) * scl, (a0[3] * t1.z - b0[3] * t1.w) * scl); w2.y = cvt_pk_bf16((a0[2] * t1.y + b0[2] * t1.x) * scl, (a0[3] * t1.w + b0[3] * t1.z) * scl);
                    w1.z = cvt_pk_bf16((a1[0] * t2.x - b1[0] * t2.y) * scl, (a1[1] * t2.z - b1[1] * t2.w) * scl); w2.z = cvt_pk_bf16((a1[0] * t2.y + b1[0] * t2.x) * scl, (a1[1] * t2.w + b1[1] * t2.z) * scl);
                    w1.w = cvt_pk_bf16((a1[2] * t3.x - b1[2] * t3.y) * scl, (a1[3] * t3.z - b1[3] * t3.w) * scl); w2.w = cvt_pk_bf16((a1[2] * t3.y + b1[2] * t3.x) * scl, (a1[3] * t3.w + b1[3] * t3.z) * scl);
                    bf16_t* rowp = O + (size_t)r * ldc + colbase;
                    *(u32x4*)rowp = w1; *(u32x4*)(rowp + 64) = w2; }
        } else if (u.pn == 26) {
            if (wc == 0 && fq < 2) {
#pragma unroll
                for (int ai = 0; ai < 2; ++ai)
#pragma unroll
                    for (int m = 0; m < 4; ++m) { float* p = dtr + (size_t)(row0 + ai * HALF + m * 16) * 16 + 8 * fq; *(f32x4*)p = acc[ai][0][m][0]; *(f32x4*)(p + 4) = acc[ai][0][m][1]; } }
        } else {
            const int col0 = u.pn * BM + wc * 32 + 8 * fq;
#pragma unroll
            for (int ai = 0; ai < 2; ++ai)
#pragma unroll
                for (int m = 0; m < 4; ++m) { bf16_t* rowp = O + (size_t)(row0 + ai * HALF + m * 16) * ldc + col0;
#pragma unroll
                    for (int bj = 0; bj < 2; ++bj) { const f32x4 v0 = acc[ai][bj][m][0], v1 = acc[ai][bj][m][1];
                        u32x4 w; w.x = cvt_pk_bf16(v0[0], v0[1]); w.y = cvt_pk_bf16(v0[2], v0[3]); w.z = cvt_pk_bf16(v1[0], v1[1]); w.w = cvt_pk_bf16(v1[2], v1[3]);
                        *(u32x4*)(rowp + bj * HALF) = w; } }
        }
    }
};

template <class Epi, class Sched, bool ALIGN_EPI = false, bool SP2 = false, int MIDK = 0>
__device__ __forceinline__ void gemm_phase(PG8_LAS unsigned char* lds, const Gemm g, const Sched& S, const Epi& E, const PG8_LAS float* rtab = nullptr) {
    int tid_ = threadIdx.x; asm volatile("" : "+v"(tid_)); const int tid = tid_, wid = __builtin_amdgcn_readfirstlane(tid >> 6), lane = tid & 63, wr = wid >> 2, wc = wid & 3, fr = lane & 15, fq = lane >> 4;
    const int K = g.K, nt = K / BK;
    unsigned voffA[2], voffB[2];
#pragma unroll
    for (int i = 0; i < 2; ++i) { int R, C; stage_rc(tid * 16 + i * 8192, R, C); const int Rb = Epi::PERM ? ((R & ~31) + perm32(R & 31)) : R;
        voffA[i] = (unsigned)(R * K + C) * 2u; voffB[i] = (unsigned)(Rb * K + C) * 2u; }
    const size_t kstep = (size_t)(BK * 2);
    const size_t hstep = (size_t)HALF * K * 2;
    const size_t tstep = 2 * hstep;
    const unsigned ldsw = (unsigned)wid * 1024u;
    const int aoff = lds_byte(wr * 64 + fr, fq * 8), boff = lds_byte(wc * 32 + fr, fq * 8);
#define PG8_SA(b, h) (((b) * 2 + (h)) * HTB)
#define PG8_SB(b, h) ((4 + (b) * 2 + (h)) * HTB)
#define PG8_STAGE(bufoff, gbase, voff) do { _Pragma("unroll") for (int _i = 0; _i < 2; ++_i) \
        __builtin_amdgcn_global_load_lds((const unsigned*)((const char*)(gbase) + (voff)[_i]), (PG8_LAS unsigned*)(lds + (bufoff) + ldsw + _i * 8192), 16, 0, 0); } while (0)
#define PG8_LDA(dst, b, h) do { _Pragma("unroll") for (int m = 0; m < 4; ++m) _Pragma("unroll") for (int k = 0; k < 2; ++k) dst[m][k] = *(const PG8_LAS bf16x8*)(lds + PG8_SA(b, h) + aoff + m * 2048 + k * 1024); } while (0)
#define PG8_LDB(dst, b, h) do { _Pragma("unroll") for (int n = 0; n < 2; ++n) _Pragma("unroll") for (int k = 0; k < 2; ++k) dst[n][k] = *(const PG8_LAS bf16x8*)(lds + PG8_SB(b, h) + boff + n * 2048 + k * 1024); } while (0)
#define PG8_MMA(ai, bj, At, Bt) do { __builtin_amdgcn_s_setprio(1); _Pragma("unroll") for (int m = 0; m < 4; ++m) _Pragma("unroll") for (int n = 0; n < 2; ++n) _Pragma("unroll") for (int k = 0; k < 2; ++k) \
        acc[ai][bj][m][n] = __builtin_amdgcn_mfma_f32_16x16x32_bf16(Bt[n][k], At[m][k], acc[ai][bj][m][n], 0, 0, 0); __builtin_amdgcn_s_setprio(0); } while (0)
#define PG8_WAIT_V(n) asm volatile("s_waitcnt vmcnt(" #n ")" ::: "memory")
#define PG8_WAIT_L(n) asm volatile("s_waitcnt lgkmcnt(" #n ")" ::: "memory")
#define PG8_BAR __builtin_amdgcn_s_barrier()
#define PG8_SCHED __builtin_amdgcn_sched_barrier(0)
    Unit cur, nxt; int ui = 0;
    if (!S.next(0, cur)) return;
    f32x4 acc[2][2][4][2];
#pragma unroll
    for (int a = 0; a < 2; ++a)
#pragma unroll
        for (int b = 0; b < 2; ++b)
#pragma unroll
            for (int m = 0; m < 4; ++m)
#pragma unroll
                for (int n = 0; n < 2; ++n) acc[a][b][m][n] = (f32x4){0.f, 0.f, 0.f, 0.f};
    bf16x8 At[4][2], B0[2][2], B1[2][2];
    const char* cA = (const char*)g.A + (size_t)cur.pm * tstep; const char* cB = (const char*)g.Bt + (size_t)cur.pn * tstep;
    S.a_ready(cur);
    if constexpr (SP2) {
        PG8_STAGE(PG8_SB(0, 0), cB, voffB); PG8_STAGE(PG8_SB(0, 1), cB + hstep, voffB); PG8_STAGE(PG8_SA(0, 0), cA, voffA); PG8_STAGE(PG8_SA(0, 1), cA + hstep, voffA);
        if (wr == 1) PG8_BAR;
        PG8_WAIT_V(2); PG8_BAR;
        PG8_STAGE(PG8_SB(1, 0), cB + kstep, voffB); PG8_STAGE(PG8_SA(1, 0), cA + kstep, voffA); PG8_STAGE(PG8_SB(1, 1), cB + hstep + kstep, voffB);
        PG8_WAIT_V(6); PG8_BAR;
    } else {
        PG8_STAGE(PG8_SB(0, 0), cB, voffB); PG8_STAGE(PG8_SA(0, 0), cA, voffA); PG8_STAGE(PG8_SB(0, 1), cB + hstep, voffB); PG8_STAGE(PG8_SA(0, 1), cA + hstep, voffA);
        if (wr == 1) PG8_BAR;
        PG8_WAIT_V(4); PG8_BAR;
        PG8_STAGE(PG8_SB(1, 0), cB + kstep, voffB); PG8_STAGE(PG8_SA(1, 0), cA + kstep, voffA); PG8_STAGE(PG8_SB(1, 1), cB + hstep + kstep, voffB);
        PG8_WAIT_V(6); PG8_BAR;
    }
    for (;;) {
        const bool has_next = S.next(ui + 1, nxt);
        const char* nA = has_next ? (const char*)g.A + (size_t)nxt.pm * tstep : cA; const char* nB = has_next ? (const char*)g.Bt + (size_t)nxt.pn * tstep : cB;
        for (int t = 0; t < nt; t += 2) {
            if constexpr (MIDK > 0) { if (t == MIDK) {
#pragma unroll
                for (int a = 0; a < 2; ++a)
#pragma unroll
                    for (int m = 0; m < 4; ++m) { const float rs = rtab[ui * 256 + a * HALF + wr * 64 + m * 16 + fr];
#pragma unroll
                        for (int b = 0; b < 2; ++b)
#pragma unroll
                            for (int n = 0; n < 2; ++n) acc[a][b][m][n] = acc[a][b][m][n] * rs; } } }
            const bool last = (t == nt - 2);
            const char* a1 = cA + (size_t)(t + 1) * kstep;
            const char* a2 = last ? nA : cA + (size_t)(t + 2) * kstep; const char* b2 = last ? nB : cB + (size_t)(t + 2) * kstep;
            const char* a3 = a2 + kstep; const char* b3 = b2 + kstep;
            if (last && has_next) S.a_ready(nxt);
            if constexpr (SP2) {
            PG8_LDB(B0, 0, 0); PG8_LDB(B1, 0, 1); PG8_SCHED; PG8_LDA(At, 0, 0); PG8_STAGE(PG8_SA(1, 1), a1 + hstep, voffA);
            PG8_WAIT_V(8); PG8_WAIT_L(0); PG8_BAR; PG8_MMA(0, 0, At, B0); PG8_MMA(0, 1, At, B1); PG8_BAR; PG8_SCHED;
            PG8_LDA(At, 0, 1); PG8_STAGE(PG8_SB(0, 0), b2, voffB); PG8_STAGE(PG8_SB(0, 1), b2 + hstep, voffB); PG8_STAGE(PG8_SA(0, 0), a2, voffA);
            PG8_WAIT_V(8); PG8_WAIT_L(0); PG8_BAR; PG8_MMA(1, 0, At, B0); PG8_MMA(1, 1, At, B1); PG8_BAR; PG8_SCHED;
            PG8_LDB(B0, 1, 0); PG8_LDB(B1, 1, 1); PG8_SCHED; PG8_LDA(At, 1, 0); PG8_STAGE(PG8_SA(0, 1), a2 + hstep, voffA);
            PG8_WAIT_V(8); PG8_WAIT_L(0); PG8_BAR; PG8_MMA(0, 0, At, B0); PG8_MMA(0, 1, At, B1); PG8_BAR; PG8_SCHED;
            PG8_LDA(At, 1, 1); PG8_STAGE(PG8_SB(1, 0), b3, voffB); PG8_STAGE(PG8_SB(1, 1), b3 + hstep, voffB); PG8_STAGE(PG8_SA(1, 0), a3, voffA);
            PG8_WAIT_V(8); PG8_WAIT_L(0); PG8_BAR; PG8_MMA(1, 0, At, B0); PG8_MMA(1, 1, At, B1); PG8_BAR; PG8_SCHED;
            } else {
            PG8_LDB(B0, 0, 0); PG8_SCHED; PG8_LDA(At, 0, 0); PG8_STAGE(PG8_SA(1, 1), a1 + hstep, voffA);
            PG8_WAIT_L(8); PG8_BAR; PG8_WAIT_L(0); PG8_MMA(0, 0, At, B0); PG8_BAR; PG8_SCHED;
            PG8_LDB(B1, 0, 1); PG8_STAGE(PG8_SB(0, 0), b2, voffB);
            PG8_BAR; PG8_WAIT_L(0); PG8_MMA(0, 1, At, B1); PG8_BAR;
            PG8_LDA(At, 0, 1); PG8_STAGE(PG8_SA(0, 0), a2, voffA);
            PG8_BAR; PG8_WAIT_L(0); PG8_MMA(1, 0, At, B0); PG8_BAR; PG8_SCHED;
            PG8_STAGE(PG8_SB(0, 1), b2 + hstep, voffB);
            PG8_WAIT_V(6); PG8_BAR; PG8_MMA(1, 1, At, B1); PG8_BAR;
            PG8_LDB(B0, 1, 0); PG8_SCHED; PG8_LDA(At, 1, 0); PG8_STAGE(PG8_SA(0, 1), a2 + hstep, voffA);
            PG8_WAIT_L(8); PG8_BAR; PG8_WAIT_L(0); PG8_MMA(0, 0, At, B0); PG8_BAR; PG8_SCHED;
            PG8_LDB(B1, 1, 1); PG8_STAGE(PG8_SB(1, 0), b3, voffB);
            PG8_BAR; PG8_WAIT_L(0); PG8_MMA(0, 1, At, B1); PG8_BAR;
            PG8_LDA(At, 1, 1); PG8_STAGE(PG8_SA(1, 0), a3, voffA);
            PG8_BAR; PG8_WAIT_L(0); PG8_MMA(1, 0, At, B0); PG8_BAR; PG8_SCHED;
            PG8_STAGE(PG8_SB(1, 1), b3 + hstep, voffB);
            PG8_WAIT_V(6); PG8_BAR; PG8_MMA(1, 1, At, B1); PG8_BAR;
            }
        }
        if constexpr (ALIGN_EPI) { if (wr == 0) PG8_BAR; }
        if constexpr (!Epi::AFTER_DRAIN) { E(acc, cur, wr, wc, fr, fq); S.done(cur); }
        if (!has_next) break;
#pragma unroll
        for (int a = 0; a < 2; ++a)
#pragma unroll
            for (int b = 0; b < 2; ++b)
#pragma unroll
                for (int m = 0; m < 4; ++m)
#pragma unroll
                    for (int n = 0; n < 2; ++n) acc[a][b][m][n] = (f32x4){0.f, 0.f, 0.f, 0.f};
        cur = nxt; cA = nA; cB = nB; ++ui;
        if constexpr (ALIGN_EPI) { if (wr == 1) PG8_BAR; }
    }
    PG8_WAIT_V(0);
    if constexpr (!ALIGN_EPI) { if (wr == 0) PG8_BAR; }
    PG8_BAR;
    if constexpr (Epi::AFTER_DRAIN) { E.fused(acc, cur, wr, wc, fr, fq, lds, wid, lane); S.done(cur); }
#undef PG8_SA
#undef PG8_SB
#undef PG8_STAGE
#undef PG8_LDA
#undef PG8_LDB
#undef PG8_MMA
#undef PG8_WAIT_V
#undef PG8_WAIT_L
#undef PG8_BAR
#undef PG8_SCHED
}
}

constexpr int NWAVES = 8, NTHR = 512;
constexpr int DM = 2048, NBATCH = 2, SEQ = 4096, MROWS = NBATCH * SEQ, DEPTH = 4;
constexpr int DFF = 5504, DFF2 = 2 * DFF;
constexpr int DSSD = 1024, NXBC = 1536, NHS = 16, HDS = 64, NST = 128;
constexpr int NHR = 8, HDR = 128;
constexpr int DIN = 6672, DINP = 6912;
constexpr int CHUNK = 128, NCH = MROWS / CHUNK;
constexpr int NMOD = 9, MODW = NMOD * DM;
constexpr float EPS = 1e-6f;
constexpr int PZ = 0, PX = 1024, PB = 2048, PC = 2304, PQ = 2560, PK = 3584, PV = 4608, PG = 5632, PDT = 6656;

constexpr size_t MiB = 1u << 20;
constexpr size_t WS_CTL = 0, CTL_ZERO_BYTES = 1 * MiB;
constexpr size_t WS_MODS = 1 * MiB;
constexpr size_t WS_ROPE = 2 * MiB;
constexpr size_t WS_DTV = 4 * MiB;
constexpr size_t WS_ACUM = WS_DTV + 512 * 1024;
constexpr size_t WS_SSQ = WS_ACUM + 512 * 1024;
constexpr size_t WS_DTR = WS_SSQ + 512 * 1024;
constexpr size_t WS_HN = 8 * MiB;
constexpr size_t WS_YMIX = 40 * MiB;
constexpr size_t WS_H1 = 72 * MiB;
constexpr size_t WS_PROJ = 160 * MiB;
constexpr size_t WS_XBCC = 268 * MiB;
constexpr size_t WS_SST = 292 * MiB;
constexpr size_t WS_SSTP = 324 * MiB;
constexpr size_t WS_KV = 356 * MiB;
constexpr size_t WS_KVP = 388 * MiB;
constexpr size_t WS_W = 420 * MiB;
constexpr size_t W13_BYTES = (size_t)DFF2 * DM * 2, W2_BYTES = (size_t)DM * DFF * 2, WIN_BYTES = (size_t)DINP * DM * 2, WOUT_BYTES = (size_t)DM * DM * 2;
constexpr size_t WL_W13 = 0, WL_W2 = 2 * W13_BYTES, WL_WIN = WL_W2 + 2 * W2_BYTES, WL_WOUT = WL_WIN + WIN_BYTES, WL_BYTES = WL_WOUT + WOUT_BYTES;
constexpr size_t WS_END = WS_W + DEPTH * WL_BYTES;
static_assert(WS_H1 + (size_t)MROWS * DFF * 2 <= WS_PROJ && WS_PROJ + (size_t)MROWS * DINP * 2 <= WS_XBCC && WS_XBCC + (size_t)MROWS * NXBC * 2 <= WS_SST, "ws map");
static_assert(W13_BYTES % 256 == 0 && W2_BYTES % 256 == 0 && WIN_BYTES % 256 == 0, "weight alignment");
constexpr int CW_BAR = 4096;

constexpr int LDS_BYTES = 147456;
constexpr int RTAB_OFF = 131072;
constexpr int MISC_OFF = 145408;

#define GAS __attribute__((address_space(1)))
#define LAS __attribute__((address_space(3)))
typedef unsigned short bf16;
typedef unsigned v4u __attribute__((ext_vector_type(4)));
typedef unsigned v2u __attribute__((ext_vector_type(2)));
typedef float f32x4 __attribute__((ext_vector_type(4)));
typedef float f32x2v __attribute__((ext_vector_type(2)));
typedef short bf16x8 __attribute__((ext_vector_type(8)));
typedef short s16x4 __attribute__((ext_vector_type(4)));
typedef GAS unsigned gu32;
#define RLX_AGENT __ATOMIC_RELAXED, __HIP_MEMORY_SCOPE_AGENT
#define LDS_WAIT() asm volatile("s_waitcnt lgkmcnt(0)" ::: "memory")
#define VM_WAIT() asm volatile("s_waitcnt vmcnt(0)" ::: "memory")
__device__ __forceinline__ unsigned pkbf(float lo, float hi) { unsigned r; asm volatile("v_cvt_pk_bf16_f32 %0, %1, %2" : "=v"(r) : "v"(lo), "v"(hi)); return r; }
__device__ __forceinline__ float bflo(unsigned w) { return __builtin_bit_cast(float, w << 16); }
__device__ __forceinline__ float bfhi(unsigned w) { return __builtin_bit_cast(float, w & 0xffff0000u); }
__device__ __forceinline__ float bf1(bf16 h) { return __builtin_bit_cast(float, (unsigned)h << 16); }
__device__ __forceinline__ float silu(float a) { return a * __builtin_amdgcn_rcpf(1.0f + __builtin_amdgcn_exp2f(-1.4426950408889634f * a)); }
__device__ __forceinline__ float fexp(float x) { return __builtin_amdgcn_exp2f(1.4426950408889634f * x); }
__device__ __forceinline__ float wave_sum(float v) {
#pragma unroll
    for (int o = 1; o < 64; o <<= 1) v += __shfl_xor(v, o);
    return v;
}
__device__ __forceinline__ float sum16(float v) {
#pragma unroll
    for (int o = 1; o < 16; o <<= 1) v += __shfl_xor(v, o);
    return v;
}
__device__ __forceinline__ bf16x8 frag_row(const LAS unsigned char* base, int stride, int row0, int k0, int lane) {
    return *(const LAS bf16x8*)(base + (row0 + (lane & 15)) * stride + (k0 + 8 * (lane >> 4)) * 2);
}
__device__ __forceinline__ bf16x8 frag_tr(const LAS unsigned char* base, int stride, int k0, int n0, int lane) {
    const int q = lane >> 4, i = lane & 15;
    const LAS unsigned char* p = base + (k0 + 8 * q + (i >> 2)) * stride + (n0 + 4 * (i & 3)) * 2;
    const s16x4 a = __builtin_amdgcn_ds_read_tr16_b64_v4i16((LAS s16x4*)p);
    const s16x4 b = __builtin_amdgcn_ds_read_tr16_b64_v4i16((LAS s16x4*)(p + 4 * stride));
    return (bf16x8){a[0], a[1], a[2], a[3], b[0], b[1], b[2], b[3]};
}
#define MFMA16(a, b, c) __builtin_amdgcn_mfma_f32_16x16x32_bf16((a), (b), (c), 0, 0, 0)

#define XB_TMO      128
#define XB_XCNT(j)  (256  + 64 * (j))
#define XB_XSUB(j)  (1280 + 64 * (j))
#define XB_XGEN(j)  (2304 + 64 * (j))
#define XB_TOP      3328
#define XB_TOPGEN   3392
#define XCD_BAR_WORDS 3456
#define XB_SPIN_CAP (1u << 18)

__device__ __forceinline__ unsigned xb_ld(unsigned* p)              { return __hip_atomic_load(p, __ATOMIC_RELAXED, __HIP_MEMORY_SCOPE_AGENT); }
__device__ __forceinline__ unsigned xb_add(unsigned* p, unsigned v) { return __hip_atomic_fetch_add(p, v, __ATOMIC_RELAXED, __HIP_MEMORY_SCOPE_AGENT); }
__device__ __forceinline__ unsigned xb_xcc_id() { return (unsigned)__builtin_amdgcn_s_getreg((3 << 11) | 20) & 0xFu; }
#define XB_SPIN(cond, bar) do { unsigned _sp = 0; while (cond) { __builtin_amdgcn_s_sleep(1); \
    if ((++_sp & 255u) == 0u) { if (xb_ld(&(bar)[XB_TMO])) break; if (_sp > XB_SPIN_CAP) { atomicAdd(&(bar)[XB_TMO], 1u); break; } } } } while (0)

struct XcdBarrier {
    unsigned* bar; unsigned x;
    volatile LAS unsigned* st;
};

__device__ __forceinline__ XcdBarrier xcd_barrier_post(unsigned* bar, volatile LAS unsigned* st) {
    XcdBarrier b; b.bar = bar; b.x = xb_xcc_id(); b.st = st;
    if (threadIdx.x == 0) (void)xb_add(&bar[XB_XCNT(b.x)], 1u);
    return b;
}
__device__ __forceinline__ void xcd_barrier_complete(unsigned* bar, unsigned x, unsigned& nloc, unsigned& nx) {
    const unsigned G = gridDim.x * gridDim.y * gridDim.z;
    unsigned sum, cnt, mine, sp = 0u;
    for (;;) {
        sum = 0u; cnt = 0u; mine = 0u;
#pragma unroll
        for (unsigned j = 0; j < 16; ++j) { const unsigned c = xb_ld(&bar[XB_XCNT(j)]); sum += c; cnt += (c > 0u) ? 1u : 0u; mine = (j == x) ? c : mine; }
        if (sum == G) break;
        __builtin_amdgcn_s_sleep(1);
        if ((++sp & 255u) == 0u) { if (xb_ld(&bar[XB_TMO])) break; if (sp > XB_SPIN_CAP) { atomicAdd(&bar[XB_TMO], 1u); break; } }
    }
    nloc = mine > 0u ? mine : 1u; nx = cnt > 0u ? cnt : 1u;
}

__device__ __forceinline__ void xcd_barrier(const XcdBarrier& b) {
    asm volatile("s_waitcnt vmcnt(0)" ::: "memory");
    __syncthreads();
    if (threadIdx.x == 0) {
        unsigned* bar = b.bar;
        __builtin_amdgcn_s_waitcnt(0);
        unsigned nloc = b.st[0], nx = b.st[1];
        if (nloc == 0u) { xcd_barrier_complete(bar, b.x, nloc, nx); b.st[0] = nloc; b.st[1] = nx; }
        const unsigned old = xb_add(&bar[XB_XSUB(b.x)], 1u);
        const unsigned gen = old / nloc;
        if (old + 1u == (gen + 1u) * nloc) {
            __builtin_amdgcn_fence(__ATOMIC_RELEASE, "agent");
            asm volatile("s_waitcnt vmcnt(0)" ::: "memory");
            const unsigned og = xb_add(&bar[XB_TOP], 1u);
            const unsigned tg = og / nx;
            if (og + 1u == (tg + 1u) * nx) xb_add(&bar[XB_TOPGEN], 1u);
            else XB_SPIN(xb_ld(&bar[XB_TOPGEN]) == tg, bar);
            __builtin_amdgcn_fence(__ATOMIC_ACQUIRE, "agent");
            xb_add(&bar[XB_XGEN(b.x)], 1u);
            asm volatile("s_waitcnt vmcnt(0)" ::: "memory");
        } else {
            XB_SPIN(xb_ld(&bar[XB_XGEN(b.x)]) == gen, bar);
            __builtin_amdgcn_fence(__ATOMIC_ACQUIRE, "agent");
            asm volatile("s_waitcnt vmcnt(0)" ::: "memory");
        }
    }
    __syncthreads();
}

struct Args { const float* in[18]; float* out; unsigned char* ws; int ph_lo, ph_hi; };
#define CAS __attribute__((address_space(4)))
struct Frame {
    LAS unsigned char* lds;
    int tid, lane, wave, vcu, G;
    const CAS Args* ap;
};
__device__ __forceinline__ void fresh(Frame& F) { int t = threadIdx.x; asm volatile("" : "+v"(t)); F.tid = t; F.lane = t & 63; F.wave = __builtin_amdgcn_readfirstlane(t >> 6);
    unsigned long long a = (unsigned long long)__builtin_amdgcn_kernarg_segment_ptr(); asm volatile("" : "+s"(a)); F.ap = (const CAS Args*)a; }
enum { I_X = 0, I_C, I_NORMW, I_MODW, I_MODB, I_W13, I_W2, I_WIN, I_CONVW, I_CONVB, I_DTB, I_ALOG, I_DSKIP, I_SSDNW, I_RETNW, I_RETNB, I_WOUT, I_FNW };

__device__ __forceinline__ void cvt_tile(const float* W, int N, bf16* WT, int K, int kb, int nb, int src_col, int nvalid, LAS float* scr, int lane, const float* kscale = nullptr, int kscale_n = 0) {
    const int k0 = 64 * kb, n0 = 32 * nb, c = lane & 31;
#pragma unroll 8
    for (int i = 0; i < 32; ++i) { const int kk = 2 * i + (lane >> 5); float v = 0.f; if (c < nvalid) v = W[(size_t)(k0 + kk) * N + src_col + c]; if (kscale && k0 + kk < kscale_n) v *= kscale[k0 + kk]; scr[kk * 33 + c] = v; }
    LDS_WAIT(); asm volatile("" ::: "memory");
    const int cch = lane & 7;
#pragma unroll
    for (int j = 0; j < 4; ++j) { const int n = (lane >> 3) + 8 * j; const LAS float* s = scr + (8 * cch) * 33 + n;
        v4u o; o.x = pkbf(s[0 * 33], s[1 * 33]); o.y = pkbf(s[2 * 33], s[3 * 33]); o.z = pkbf(s[4 * 33], s[5 * 33]); o.w = pkbf(s[6 * 33], s[7 * 33]);
        *(GAS v4u*)(WT + (size_t)(n0 + n) * K + k0 + 8 * cch) = o; }
    LDS_WAIT(); asm volatile("" ::: "memory");
}
constexpr int IT_W13 = (DM / 64) * (DFF2 / 32), IT_W2 = (DFF / 64) * (DM / 32), IT_WIN = (DM / 64) * (DINP / 32), IT_WOUT = (DM / 64) * (DM / 32);
constexpr int IT_LAYER = 2 * IT_W13 + 2 * IT_W2 + IT_WIN + IT_WOUT, IT_ALL = DEPTH * IT_LAYER;
__device__ __forceinline__ void cvt_item(Frame& F, int it, LAS float* scr) {
    const int l = it / IT_LAYER; int r = it % IT_LAYER;
    unsigned char* wl = F.ap->ws + WS_W + (size_t)l * WL_BYTES;
    if (r < 2 * IT_W13) { const int f = r / IT_W13, r2 = r % IT_W13, kb = r2 / (DFF2 / 32), nb = r2 % (DFF2 / 32);
        const int T = nb >> 3, hf = (nb >> 2) & 1, sub = nb & 3;
        cvt_tile(F.ap->in[I_W13] + (size_t)(l * 2 + f) * DM * DFF2, DFF2, (bf16*)(wl + WL_W13 + (size_t)f * W13_BYTES), DM, kb, nb, hf * DFF + T * 128 + sub * 32, 32, scr, F.lane); return; }
    r -= 2 * IT_W13;
    if (r < 2 * IT_W2) { const int f = r / IT_W2, r2 = r % IT_W2, kb = r2 / (DM / 32), nb = r2 % (DM / 32);
        cvt_tile(F.ap->in[I_W2] + (size_t)(l * 2 + f) * DFF * DM, DM, (bf16*)(wl + WL_W2 + (size_t)f * W2_BYTES), DFF, kb, nb, 32 * nb, 32, scr, F.lane); return; }
    r -= 2 * IT_W2;
    if (r < IT_WIN) { const int kb = r / (DINP / 32), nb = r % (DINP / 32);
        int src = 32 * nb, nv = 32;
        if (nb >= 80 && nb < 144) { const int j = (nb - 80) & 31, T = j >> 3, hf = (j >> 2) & 1, hh = (j >> 1) & 1, isub = j & 1;
            src = (nb < 112 ? 2576 : 3600) + (2 * T + hh) * 128 + hf * 64 + isub * 32; }
        else if (nb >= 144 && nb < 208) src = 32 * nb + 16; else if (nb == 208) { src = 2560; nv = 16; } else if (nb > 208) { src = 0; nv = 0; }
        cvt_tile(F.ap->in[I_WIN] + (size_t)l * DM * DIN, DIN, (bf16*)(wl + WL_WIN), DM, kb, nb, src, nv, scr, F.lane); return; }
    r -= IT_WIN;
    { const int kb = r / (DM / 32), nb = r % (DM / 32);
      cvt_tile(F.ap->in[I_WOUT] + (size_t)l * DM * DM, DM, (bf16*)(wl + WL_WOUT), DM, kb, nb, 32 * nb, 32, scr, F.lane, F.ap->in[I_SSDNW] + (size_t)l * DSSD, DSSD); }
}
__device__ __forceinline__ void p0_prologue(Frame& F) {
    fresh(F);
    LAS float* cact = (LAS float*)F.lds;
    LAS float* red = (LAS float*)(F.lds + 16384);
    for (int i = F.tid; i < 2 * DM; i += NTHR) { const float cv = F.ap->in[I_C][i]; cact[i] = cv / (1.0f + expf(-cv)); }
    __syncthreads();
    float* MODS = (float*)(F.ap->ws + WS_MODS);
    for (int it = blockIdx.x; it < 256; it += F.G) {
        const int l = it >> 6, cb = (it & 63) * 288;
        if (F.tid < 504) {
            const int cq = F.tid % 72, kg = F.tid / 72;
            const float* wp = F.ap->in[I_MODW] + (size_t)l * DM * MODW + cb + 4 * cq;
            f32x4 a0 = {0.f, 0.f, 0.f, 0.f}, a1 = {0.f, 0.f, 0.f, 0.f};
#pragma unroll 8
            for (int k = kg; k < DM; k += 7) { const f32x4 w = *(const f32x4*)(wp + (size_t)k * MODW); a0 += cact[k] * w; a1 += cact[DM + k] * w; }
            *(LAS f32x4*)(red + (kg * 2 + 0) * 288 + 4 * cq) = a0; *(LAS f32x4*)(red + (kg * 2 + 1) * 288 + 4 * cq) = a1;
        }
        __syncthreads();
        for (int o = F.tid; o < 576; o += NTHR) { const int b = o / 288, col = o % 288; float s = F.ap->in[I_MODB][l * MODW + cb + col];
#pragma unroll
            for (int kg = 0; kg < 7; ++kg) s += red[(kg * 2 + b) * 288 + col];
            MODS[(size_t)(l * 2 + b) * MODW + cb + col] = s; }
        __syncthreads();
    }
    const int gtid = F.vcu * NTHR + F.tid, NT = F.G * NTHR;
    f32x2v* ROPE = (f32x2v*)(F.ap->ws + WS_ROPE);
    for (int idx = gtid; idx < SEQ * 64; idx += NT) { const int pos = idx >> 6, i = idx & 63;
        const float inv = (float)exp2(-(double)i * (13.287712379549449 / 64.0)); const float ang = (float)pos * inv; float s, c; sincosf(ang, &s, &c); ROPE[idx] = (f32x2v){c, s}; }
    LAS float* scr = (LAS float*)(F.lds + F.wave * 16384);
    const int gw = F.vcu * NWAVES + F.wave, NGW = F.G * NWAVES;
    for (int it = gw; it < IT_ALL; it += NGW) cvt_item(F, it, scr);
}

__device__ __forceinline__ void ph_modnorm(Frame& F, const float* xsrc, const float* nw, const float* mods_l, int jshift) {
    fresh(F);
    bf16* HN = (bf16*)(F.ap->ws + WS_HN);
    const int gw = F.vcu * NWAVES + F.wave, NGW = F.G * NWAVES;
    for (int m = gw; m < MROWS; m += NGW) {
        const float* sh = mods_l + (size_t)(m >> 12) * MODW + jshift * DM; const float* sc = sh + DM;
        const GAS f32x4* xr = (const GAS f32x4*)(xsrc + (size_t)m * DM) + F.lane;
        f32x4 v[8]; float s = 0.f;
#pragma unroll
        for (int j = 0; j < 8; ++j) { v[j] = xr[64 * j]; s += (v[j].x * v[j].x + v[j].y * v[j].y) + (v[j].z * v[j].z + v[j].w * v[j].w); }
        const float rstd = 1.0f / sqrtf(wave_sum(s) * (1.0f / DM) + EPS);
#pragma unroll
        for (int j = 0; j < 8; ++j) { const int col = 4 * F.lane + 256 * j;
            const f32x4 w4 = *(const f32x4*)(nw + col), sc4 = *(const f32x4*)(sc + col), sh4 = *(const f32x4*)(sh + col);
            const f32x4 h = v[j] * rstd * w4 * (1.0f + sc4) + sh4;
            v2u o; o.x = pkbf(h.x, h.y); o.y = pkbf(h.z, h.w);
            *(GAS v2u*)(HN + (size_t)m * DM + col) = o; }
    }
}
__device__ __forceinline__ void ph_finalnorm(Frame& F) {
    fresh(F);
    const int gw = F.vcu * NWAVES + F.wave, NGW = F.G * NWAVES; const float* nw = F.ap->in[I_FNW];
    for (int m = gw; m < MROWS; m += NGW) {
        GAS f32x4* xr = (GAS f32x4*)(F.ap->out + (size_t)m * DM) + F.lane;
        f32x4 v[8]; float s = 0.f;
#pragma unroll
        for (int j = 0; j < 8; ++j) { v[j] = xr[64 * j]; s += (v[j].x * v[j].x + v[j].y * v[j].y) + (v[j].z * v[j].z + v[j].w * v[j].w); }
        const float rstd = 1.0f / sqrtf(wave_sum(s) * (1.0f / DM) + EPS);
#pragma unroll
        for (int j = 0; j < 8; ++j) { const f32x4 w4 = *(const f32x4*)(nw + 4 * F.lane + 256 * j); xr[64 * j] = v[j] * rstd * w4; }
    }
}
constexpr int ST128 = 272, ST64 = 144;
__device__ __forceinline__ float ret_lg2(int h) { return log2f(1.0f - exp2f(-5.0f - (float)h)); }
__device__ __forceinline__ unsigned short bf16_of(float v) { return (unsigned short)(pkbf(v, 0.f) & 0xffffu); }
template <int NR> __device__ __forceinline__ void conv_rows(const bf16* PROJ, int mfirst, int ch0, const float* cw, const float* cb, v4u (&out)[NR]) {
    v4u raw[NR + 3]; const int tt = mfirst & (SEQ - 1);
#pragma unroll
    for (int j = 0; j < NR + 3; ++j) { raw[j] = (v4u){0u, 0u, 0u, 0u}; if (tt + j - 3 >= 0) raw[j] = *(const GAS v4u*)(PROJ + (size_t)(mfirst + j - 3) * DINP + PX + ch0); }
    f32x4 w[4][2];
#pragma unroll
    for (int k = 0; k < 4; ++k) { w[k][0] = *(const f32x4*)(cw + k * NXBC + ch0); w[k][1] = *(const f32x4*)(cw + k * NXBC + ch0 + 4); }
    const f32x4 b0 = *(const f32x4*)(cb + ch0), b1 = *(const f32x4*)(cb + ch0 + 4);
#pragma unroll
    for (int r = 0; r < NR; ++r) { f32x4 a0 = b0, a1 = b1;
#pragma unroll
        for (int k = 0; k < 4; ++k) { const v4u x = raw[r + k];
            a0 += w[k][0] * (f32x4){bflo(x.x), bfhi(x.x), bflo(x.y), bfhi(x.y)}; a1 += w[k][1] * (f32x4){bflo(x.z), bfhi(x.z), bflo(x.w), bfhi(x.w)}; }
        out[r] = (v4u){pkbf(silu(a0.x), silu(a0.y)), pkbf(silu(a0.z), silu(a0.w)), pkbf(silu(a1.x), silu(a1.y)), pkbf(silu(a1.z), silu(a1.w))}; }
}
__device__ __forceinline__ v4u scale8(v4u raw, float s) { return (v4u){pkbf(bflo(raw.x) * s, bfhi(raw.x) * s), pkbf(bflo(raw.y) * s, bfhi(raw.y) * s), pkbf(bflo(raw.z) * s, bfhi(raw.z) * s), pkbf(bflo(raw.w) * s, bfhi(raw.w) * s)}; }

__device__ __forceinline__ void ssd_states_item(Frame& F, int l, int chunk, int g, int hq) {
    const bf16* PROJ = (const bf16*)(F.ap->ws + WS_PROJ); bf16* XBCC = (bf16*)(F.ap->ws + WS_XBCC);
    float* DTV = (float*)(F.ap->ws + WS_DTV); float* ACUM = (float*)(F.ap->ws + WS_ACUM); const float* DTR = (const float*)(F.ap->ws + WS_DTR); float* SST = (float*)(F.ap->ws + WS_SST);
    const float* cw = F.ap->in[I_CONVW] + (size_t)l * 4 * NXBC; const float* cb = F.ap->in[I_CONVB] + (size_t)l * NXBC;
    LAS unsigned char* Bs = F.lds; LAS unsigned char* XW = F.lds + 34816; LAS float* ACs = (LAS float*)(F.lds + 53248); LAS float* DTs = ACs + 512;
    const int m0 = chunk * CHUNK, q = F.lane >> 4, i = F.lane & 15;
    __syncthreads();
    if (F.wave < 4) { const int h = 8 * g + 4 * hq + F.wave; const float A = -expf(F.ap->in[I_ALOG][l * NHS + h]), bias = F.ap->in[I_DTB][l * NHS + h];
        const float x0 = DTR[(size_t)(m0 + 2 * F.lane) * NHS + h] + bias, x1 = DTR[(size_t)(m0 + 2 * F.lane + 1) * NHS + h] + bias;
        const float dt0 = x0 > 20.f ? x0 : log1pf(expf(x0)), dt1 = x1 > 20.f ? x1 : log1pf(expf(x1));
        const float a0 = dt0 * A, a1 = dt1 * A, pair = a0 + a1; float incl = pair;
#pragma unroll
        for (int o = 1; o < 64; o <<= 1) { const float t = __shfl_up(incl, o); if (F.lane >= o) incl += t; }
        const float c0 = incl - pair + a0, c1 = c0 + a1;
        ACs[F.wave * 128 + 2 * F.lane] = c0; ACs[F.wave * 128 + 2 * F.lane + 1] = c1; DTs[F.wave * 128 + 2 * F.lane] = dt0; DTs[F.wave * 128 + 2 * F.lane + 1] = dt1;
        DTV[(size_t)(m0 + 2 * F.lane) * NHS + h] = dt0; DTV[(size_t)(m0 + 2 * F.lane + 1) * NHS + h] = dt1; ACUM[(size_t)(m0 + 2 * F.lane) * NHS + h] = c0; ACUM[(size_t)(m0 + 2 * F.lane + 1) * NHS + h] = c1; }
    { const int cc = F.tid & 15, rg = F.tid >> 4, ch0 = DSSD + 128 * g + 8 * cc; v4u o[4]; conv_rows<4>(PROJ, m0 + 4 * rg, ch0, cw, cb, o);
#pragma unroll
      for (int r = 0; r < 4; ++r) { *(LAS v4u*)(Bs + (4 * rg + r) * ST128 + cc * 16) = o[r]; if (hq == 0) *(GAS v4u*)(XBCC + (size_t)(m0 + 4 * rg + r) * NXBC + ch0) = o[r]; }
      if (hq == 1) { conv_rows<4>(PROJ, m0 + 4 * rg, ch0 + 256, cw, cb, o);
#pragma unroll
          for (int r = 0; r < 4; ++r) *(GAS v4u*)(XBCC + (size_t)(m0 + 4 * rg + r) * NXBC + ch0 + 256) = o[r]; } }
    __syncthreads();
    for (int hh = 0; hh < 4; ++hh) {
        const int h = 8 * g + 4 * hq + hh;
        { const int cc = F.tid & 7, rg = F.tid >> 3, ch0 = HDS * h + 8 * cc; v4u o[2]; conv_rows<2>(PROJ, m0 + 2 * rg, ch0, cw, cb, o);
          const float alast = ACs[hh * 128 + 127];
#pragma unroll
          for (int r = 0; r < 2; ++r) { const int row = 2 * rg + r; const float wl = DTs[hh * 128 + row] * fexp(alast - ACs[hh * 128 + row]);
              *(GAS v4u*)(XBCC + (size_t)(m0 + row) * NXBC + ch0) = o[r]; *(LAS v4u*)(XW + row * ST64 + cc * 16) = scale8(o[r], wl); } }
        __syncthreads();
        const int rt = F.wave & 3, ct0 = 4 * (F.wave >> 2);
        f32x4 acc[4];
#pragma unroll
        for (int c4 = 0; c4 < 4; ++c4) acc[c4] = (f32x4){0.f, 0.f, 0.f, 0.f};
#pragma unroll
        for (int ks = 0; ks < 4; ++ks) { const bf16x8 a = frag_tr(XW, ST64, 32 * ks, 16 * rt, F.lane);
#pragma unroll
            for (int c4 = 0; c4 < 4; ++c4) { const bf16x8 b = frag_tr(Bs, ST128, 32 * ks, 16 * (ct0 + c4), F.lane); acc[c4] = MFMA16(a, b, acc[c4]); } }
        float* dst = SST + (size_t)(chunk * NHS + h) * HDS * NST;
#pragma unroll
        for (int c4 = 0; c4 < 4; ++c4)
#pragma unroll
            for (int reg = 0; reg < 4; ++reg) dst[(16 * rt + 4 * q + reg) * NST + 16 * (ct0 + c4) + i] = acc[c4][reg];
        __syncthreads();
    }
}
__device__ __forceinline__ void ret_kv_item(Frame& F, int item) {
    const bf16* PROJ = (const bf16*)(F.ap->ws + WS_PROJ); float* KV = (float*)(F.ap->ws + WS_KV);
    LAS unsigned char* KW = F.lds; LAS unsigned char* VS = F.lds + 34816;
    const int chunk = item >> 3, h = item & 7, m0 = chunk * CHUNK, q = F.lane >> 4, i = F.lane & 15;
    const float lg2 = ret_lg2(h);
    __syncthreads();
    for (int c = F.tid; c < 2048; c += NTHR) { const int row = c >> 4, cc = c & 15; const float kd = __builtin_amdgcn_exp2f((float)(127 - row) * lg2);
        const v4u raw = *(const GAS v4u*)(PROJ + (size_t)(m0 + row) * DINP + PK + HDR * h + 8 * cc);
        *(LAS v4u*)(KW + row * ST128 + cc * 16) = scale8(raw, kd);
        *(LAS v4u*)(VS + row * ST128 + cc * 16) = *(const GAS v4u*)(PROJ + (size_t)(m0 + row) * DINP + PV + HDR * h + 8 * cc); }
    __syncthreads();
    f32x4 acc[8];
#pragma unroll
    for (int et = 0; et < 8; ++et) acc[et] = (f32x4){0.f, 0.f, 0.f, 0.f};
#pragma unroll
    for (int ks = 0; ks < 4; ++ks) { const bf16x8 a = frag_tr(KW, ST128, 32 * ks, 16 * F.wave, F.lane);
#pragma unroll
        for (int et = 0; et < 8; ++et) { const bf16x8 b = frag_tr(VS, ST128, 32 * ks, 16 * et, F.lane); acc[et] = MFMA16(a, b, acc[et]); } }
    float* dst = KV + (size_t)(chunk * NHR + h) * HDR * HDR;
#pragma unroll
    for (int et = 0; et < 8; ++et)
#pragma unroll
        for (int reg = 0; reg < 4; ++reg) dst[(16 * F.wave + 4 * q + reg) * HDR + 16 * et + i] = acc[et][reg];
}
__device__ __forceinline__ void ph_states(Frame& F, int l) {
    fresh(F);
    for (int v = blockIdx.x; v < 256; v += F.G) {
        ssd_states_item(F, l, v >> 2, (v >> 1) & 1, v & 1);
#pragma nounroll
        for (int k = 0; k < 2; ++k) ret_kv_item(F, 2 * v + k);
    }
}
__device__ __forceinline__ void ph_scan(Frame& F) {
    fresh(F);
    const float* ACUM = (const float*)(F.ap->ws + WS_ACUM);
    const int gtid = F.vcu * NTHR + F.tid, NT = F.G * NTHR;
    for (int s = gtid; s < 131072; s += NT) {
        const bool ssd = s < 65536; const int s2 = s & 65535, b = s2 >> 15;
        const int h = ssd ? (s2 >> 11) & 15 : (s2 >> 12) & 7, idx = ssd ? (s2 & 2047) : (s2 & 4095);
        const int nh = ssd ? NHS : NHR, per = ssd ? 2048 : 4096;
        const f32x4* src = (const f32x4*)(F.ap->ws + (ssd ? WS_SST : WS_KV)); v2u* dst = (v2u*)(F.ap->ws + (ssd ? WS_SSTP : WS_KVP));
        const float dret = __builtin_amdgcn_exp2f(128.0f * ret_lg2(h));
        f32x4 carry = {0.f, 0.f, 0.f, 0.f};
        for (int c0 = 0; c0 < 32; c0 += 8) {
            f32x4 sv[8]; float dv[8];
#pragma unroll
            for (int k = 0; k < 8; ++k) { const int cg = b * 32 + c0 + k; sv[k] = src[(size_t)(cg * nh + h) * per + idx]; dv[k] = ssd ? fexp(ACUM[(size_t)(cg * CHUNK + 127) * NHS + h]) : dret; }
#pragma unroll
            for (int k = 0; k < 8; ++k) { const int cg = b * 32 + c0 + k; dst[(size_t)(cg * nh + h) * per + idx] = (v2u){pkbf(carry.x, carry.y), pkbf(carry.z, carry.w)}; carry = carry * dv[k] + sv[k]; }
        }
    }
}
__device__ __forceinline__ void ssd_out_item(Frame& F, int l, int chunk, int g, int hq) {
    const bf16* XBCC = (const bf16*)(F.ap->ws + WS_XBCC); const bf16* PROJ = (const bf16*)(F.ap->ws + WS_PROJ);
    const float* DTV = (const float*)(F.ap->ws + WS_DTV); const float* ACUM = (const float*)(F.ap->ws + WS_ACUM); const bf16* SSTP = (const bf16*)(F.ap->ws + WS_SSTP);
    bf16* YMIX = (bf16*)(F.ap->ws + WS_YMIX); float* SSQ = (float*)(F.ap->ws + WS_SSQ);
    LAS unsigned char* Cs = F.lds; LAS unsigned char* Bs = F.lds + 34816; LAS unsigned char* PVs = Bs;
    LAS unsigned char* GW = F.lds + 69632 + F.wave * (16 * ST128); LAS unsigned char* XS = F.lds + 104448;
    LAS float* AC = (LAS float*)(F.lds + 122880); LAS float* DTs = AC + 128;
    const int m0 = chunk * CHUNK, q = F.lane >> 4, i = F.lane & 15, w = F.wave, h0 = 8 * g + 4 * hq;
    LAS unsigned char* ZS = F.lds + 123904;
    v4u xsr[2], zsr[2], pvr[2]; float acr = 0.f, dtr = 0.f;
#define SSD_PREFETCH(h_) do { const int h__ = (h_); \
        _Pragma("unroll") for (int k = 0; k < 2; ++k) { const int c = F.tid + NTHR * k, row = c >> 3, cc = c & 7; xsr[k] = *(const GAS v4u*)(XBCC + (size_t)(m0 + row) * NXBC + HDS * h__ + 8 * cc); zsr[k] = *(const GAS v4u*)(PROJ + (size_t)(m0 + row) * DINP + PZ + HDS * h__ + 8 * cc); } \
        { const GAS v4u* src = (const GAS v4u*)(SSTP + (size_t)(chunk * NHS + h__) * HDS * NST); _Pragma("unroll") for (int k = 0; k < 2; ++k) pvr[k] = src[F.tid + NTHR * k]; } \
        if (F.tid < 128) { acr = ACUM[(size_t)(m0 + F.tid) * NHS + h__]; dtr = DTV[(size_t)(m0 + F.tid) * NHS + h__]; } } while (0)
    __syncthreads();
    for (int c = F.tid; c < 2048; c += NTHR) { const int row = c >> 4, cc = c & 15;
        *(LAS v4u*)(Bs + row * ST128 + cc * 16) = *(const GAS v4u*)(XBCC + (size_t)(m0 + row) * NXBC + DSSD + 128 * g + 8 * cc);
        *(LAS v4u*)(Cs + row * ST128 + cc * 16) = *(const GAS v4u*)(XBCC + (size_t)(m0 + row) * NXBC + DSSD + 256 + 128 * g + 8 * cc); }
    for (int c = F.lane; c < 16 * ST128 / 16; c += 64) *(LAS v4u*)(GW + c * 16) = (v4u){0u, 0u, 0u, 0u};
    SSD_PREFETCH(h0);
    __syncthreads();
    bf16x8 cfrag[4];
#pragma unroll
    for (int ks = 0; ks < 4; ++ks) cfrag[ks] = frag_row(Cs, ST128, 16 * w, 32 * ks, F.lane);
    f32x4 cbT[8];
#pragma unroll
    for (int st = 0; st < 8; ++st) { cbT[st] = (f32x4){0.f, 0.f, 0.f, 0.f};
        if (st <= w) {
#pragma unroll
            for (int ks = 0; ks < 4; ++ks) { const bf16x8 a = frag_row(Bs, ST128, 16 * st, 32 * ks, F.lane); cbT[st] = MFMA16(a, cfrag[ks], cbT[st]); } } }
    __syncthreads();
    for (int hh = 0; hh < 4; ++hh) {
        const int h = h0 + hh;
#pragma unroll
        for (int k = 0; k < 2; ++k) { const int c = F.tid + NTHR * k, row = c >> 3, cc = c & 7; *(LAS v4u*)(XS + row * ST64 + cc * 16) = xsr[k]; *(LAS v4u*)(ZS + row * ST64 + cc * 16) = zsr[k]; }
#pragma unroll
        for (int k = 0; k < 2; ++k) { const int c = F.tid + NTHR * k, p = c >> 4, n8 = c & 15; *(LAS v4u*)(PVs + p * ST128 + n8 * 16) = pvr[k]; }
        if (F.tid < 128) { AC[F.tid] = acr; DTs[F.tid] = dtr; }
        __syncthreads();
        if (hh < 3) SSD_PREFETCH(h + 1);
        const float al = AC[16 * w + i];
#pragma unroll
        for (int st = 0; st < 8; ++st) { if (st <= w) {
            const f32x4 as4 = *(const LAS f32x4*)(AC + 16 * st + 4 * q), dt4 = *(const LAS f32x4*)(DTs + 16 * st + 4 * q);
            float val[4];
#pragma unroll
            for (int reg = 0; reg < 4; ++reg) { const int s = 16 * st + 4 * q + reg, lr = 16 * w + i; const float x = cbT[st][reg] * fexp(al - as4[reg]) * dt4[reg]; val[reg] = (s <= lr) ? x : 0.f; }
            *(LAS v2u*)(GW + i * ST128 + (16 * st + 4 * q) * 2) = (v2u){pkbf(val[0], val[1]), pkbf(val[2], val[3])}; } }
        LDS_WAIT(); asm volatile("" ::: "memory");
        f32x4 y[4];
#pragma unroll
        for (int pt = 0; pt < 4; ++pt) y[pt] = (f32x4){0.f, 0.f, 0.f, 0.f};
#pragma unroll
        for (int ks = 0; ks < 4; ++ks)
#pragma unroll
            for (int pt = 0; pt < 4; ++pt) { const bf16x8 b = frag_row(PVs, ST128, 16 * pt, 32 * ks, F.lane); y[pt] = MFMA16(cfrag[ks], b, y[pt]); }
        { const f32x4 a4 = *(const LAS f32x4*)(AC + 16 * w + 4 * q); const f32x4 ea = {fexp(a4.x), fexp(a4.y), fexp(a4.z), fexp(a4.w)};
#pragma unroll
          for (int pt = 0; pt < 4; ++pt) y[pt] = y[pt] * ea; }
#pragma unroll
        for (int ks = 0; ks < 4; ++ks) { if (ks <= (w >> 1)) { const bf16x8 a = frag_row(GW, ST128, 0, 32 * ks, F.lane);
#pragma unroll
            for (int pt = 0; pt < 4; ++pt) { const bf16x8 b = frag_tr(XS, ST64, 32 * ks, 16 * pt, F.lane); y[pt] = MFMA16(a, b, y[pt]); } } }
        const float Dh = F.ap->in[I_DSKIP][l * NHS + h];
        float ssq[4] = {0.f, 0.f, 0.f, 0.f};
#pragma unroll
        for (int pt = 0; pt < 4; ++pt)
#pragma unroll
            for (int reg = 0; reg < 4; ++reg) { const int lr = 16 * w + 4 * q + reg, p = 16 * pt + i;
                const float xv = bf1(*(const LAS bf16*)(XS + lr * ST64 + p * 2)), zv = bf1(*(const LAS bf16*)(ZS + lr * ST64 + p * 2));
                const float v = (y[pt][reg] + xv * Dh) * silu(zv);
                YMIX[(size_t)(m0 + lr) * DM + HDS * h + p] = bf16_of(v); ssq[reg] += v * v; }
#pragma unroll
        for (int reg = 0; reg < 4; ++reg) { const float s = sum16(ssq[reg]); if (i == 0) SSQ[(size_t)(m0 + 16 * w + 4 * q + reg) * NHS + h] = s; }
        __syncthreads();
    }
#undef SSD_PREFETCH
}
__device__ __forceinline__ void ret_out_item(Frame& F, int l, int item) {
    const bf16* PROJ = (const bf16*)(F.ap->ws + WS_PROJ); const bf16* KVP = (const bf16*)(F.ap->ws + WS_KVP); bf16* YMIX = (bf16*)(F.ap->ws + WS_YMIX);
    LAS unsigned char* Qs = F.lds; LAS unsigned char* PVs = Qs; LAS unsigned char* Ks = F.lds + 34816; LAS unsigned char* Vs = F.lds + 69632;
    LAS unsigned char* PW = F.lds + 104448 + F.wave * (16 * ST128);
    const int chunk = item >> 3, h = item & 7, m0 = chunk * CHUNK, q = F.lane >> 4, i = F.lane & 15, w = F.wave;
    const float lg2 = ret_lg2(h);
    __syncthreads();
    for (int c = F.tid; c < 2048; c += NTHR) { const int row = c >> 4, cc = c & 15; const bf16* src = PROJ + (size_t)(m0 + row) * DINP + HDR * h + 8 * cc;
        *(LAS v4u*)(Qs + row * ST128 + cc * 16) = *(const GAS v4u*)(src + PQ);
        *(LAS v4u*)(Ks + row * ST128 + cc * 16) = *(const GAS v4u*)(src + PK);
        *(LAS v4u*)(Vs + row * ST128 + cc * 16) = *(const GAS v4u*)(src + PV); }
    for (int c = F.lane; c < 16 * ST128 / 16; c += 64) *(LAS v4u*)(PW + c * 16) = (v4u){0u, 0u, 0u, 0u};
    v4u pvr[4];
    { const GAS v4u* src = (const GAS v4u*)(KVP + (size_t)(chunk * NHR + h) * HDR * HDR);
#pragma unroll
      for (int k = 0; k < 4; ++k) pvr[k] = src[F.tid + NTHR * k]; }
    __syncthreads();
    bf16x8 qfrag[4];
#pragma unroll
    for (int ks = 0; ks < 4; ++ks) qfrag[ks] = frag_row(Qs, ST128, 16 * w, 32 * ks, F.lane);
    LDS_WAIT();
    __syncthreads();
#pragma unroll
    for (int k = 0; k < 4; ++k) { const int c = F.tid + NTHR * k, d = c >> 4, e8 = c & 15; *(LAS v4u*)(PVs + d * ST128 + e8 * 16) = pvr[k]; }
    bf16 gr[32];
#pragma unroll
    for (int reg = 0; reg < 4; ++reg)
#pragma unroll
        for (int et = 0; et < 8; ++et) gr[reg * 8 + et] = PROJ[(size_t)(m0 + 16 * w + 4 * q + reg) * DINP + PG + HDR * h + 16 * et + i];
#pragma unroll
    for (int st = 0; st < 8; ++st) { if (st <= w) {
        f32x4 sT = {0.f, 0.f, 0.f, 0.f};
#pragma unroll
        for (int ks = 0; ks < 4; ++ks) { const bf16x8 a = frag_row(Ks, ST128, 16 * st, 32 * ks, F.lane); sT = MFMA16(a, qfrag[ks], sT); }
        float val[4];
#pragma unroll
        for (int reg = 0; reg < 4; ++reg) { const int d = 16 * w + i - (16 * st + 4 * q + reg); const float x = sT[reg] * __builtin_amdgcn_exp2f((float)d * lg2); val[reg] = (d >= 0) ? x : 0.f; }
        *(LAS v2u*)(PW + i * ST128 + (16 * st + 4 * q) * 2) = (v2u){pkbf(val[0], val[1]), pkbf(val[2], val[3])}; } }
    __syncthreads();
    f32x4 o[8];
#pragma unroll
    for (int et = 0; et < 8; ++et) o[et] = (f32x4){0.f, 0.f, 0.f, 0.f};
#pragma unroll
    for (int ks = 0; ks < 4; ++ks)
#pragma unroll
        for (int et = 0; et < 8; ++et) { const bf16x8 b = frag_tr(PVs, ST128, 32 * ks, 16 * et, F.lane); o[et] = MFMA16(qfrag[ks], b, o[et]); }
    { f32x4 qd;
#pragma unroll
      for (int reg = 0; reg < 4; ++reg) qd[reg] = __builtin_amdgcn_exp2f((float)(16 * w + 4 * q + reg + 1) * lg2);
#pragma unroll
      for (int et = 0; et < 8; ++et) o[et] = o[et] * qd; }
#pragma unroll
    for (int ks = 0; ks < 4; ++ks) { if (ks <= (w >> 1)) { const bf16x8 a = frag_row(PW, ST128, 0, 32 * ks, F.lane);
#pragma unroll
        for (int et = 0; et < 8; ++et) { const bf16x8 b = frag_tr(Vs, ST128, 32 * ks, 16 * et, F.lane); o[et] = MFMA16(a, b, o[et]); } } }
    const float* gnw = F.ap->in[I_RETNW] + (size_t)l * DSSD + HDR * h; const float* gnb = F.ap->in[I_RETNB] + (size_t)l * DSSD + HDR * h;
#pragma unroll
    for (int reg = 0; reg < 4; ++reg) {
        float s = 0.f;
#pragma unroll
        for (int et = 0; et < 8; ++et) s += o[et][reg];
        const float mu = sum16(s) * (1.0f / HDR); float vs = 0.f;
#pragma unroll
        for (int et = 0; et < 8; ++et) { const float d = o[et][reg] - mu; vs += d * d; }
        const float rstd = 1.0f / sqrtf(sum16(vs) * (1.0f / HDR) + EPS);
        const int lr = 16 * w + 4 * q + reg;
#pragma unroll
        for (int et = 0; et < 8; ++et) { const int e = 16 * et + i; const float on = (o[et][reg] - mu) * rstd * gnw[e] + gnb[e];
            YMIX[(size_t)(m0 + lr) * DM + DSSD + HDR * h + e] = bf16_of(silu(bf1(gr[reg * 8 + et])) * on); }
    }
}
__device__ __forceinline__ void ph_outputs(Frame& F, int l) {
    fresh(F);
    for (int v = blockIdx.x; v < 256; v += F.G) {
        ssd_out_item(F, l, v >> 2, (v >> 1) & 1, v & 1);
#pragma nounroll
        for (int k = 0; k < 2; ++k) ret_out_item(F, l, 2 * v + k);
    }
}
__device__ __forceinline__ void build_rtab(Frame& F, const pg8::StaticOrder& S) {
    fresh(F);
    const float* SSQ = (const float*)(F.ap->ws + WS_SSQ); LAS float* rtab = (LAS float*)(F.lds + RTAB_OFF);
    for (int ui = 0; ui < 8; ++ui) { pg8::Unit u; if (!S.next(ui, u)) break;
        if (F.tid < 256) { const f32x4* sq = (const f32x4*)(SSQ + (size_t)(u.pm * 256 + F.tid) * NHS); const f32x4 s0 = sq[0], s1 = sq[1], s2 = sq[2], s3 = sq[3];
            const float tot = ((s0.x + s0.y) + (s0.z + s0.w)) + ((s1.x + s1.y) + (s1.z + s1.w)) + ((s2.x + s2.y) + (s2.z + s2.w)) + ((s3.x + s3.y) + (s3.z + s3.w));
            rtab[ui * 256 + F.tid] = 1.0f / sqrtf(tot * (1.0f / DSSD) + EPS); } }
    __syncthreads();
}
#ifndef PROBE_DUP
#define PROBE_DUP 0
#endif
#define DUP(bit) (((PROBE_DUP) >> (bit)) & 1)
constexpr int PH_PER_LAYER = 12, NPH = 2 + DEPTH * PH_PER_LAYER;
__global__ void __launch_bounds__(NTHR, 2) mk_fwd(Args args) {
    extern __shared__ __attribute__((aligned(16))) unsigned char lds[];
    Frame F;
    F.lds = (LAS unsigned char*)lds;
    F.G = gridDim.x; { const int bx = blockIdx.x; F.vcu = (F.G % 8 == 0) ? (bx % 8) * (F.G / 8) + bx / 8 : bx; }
    fresh(F);
    volatile LAS unsigned* MISC = (volatile LAS unsigned*)(F.lds + MISC_OFF);
    for (int u = F.tid; u < (LDS_BYTES - MISC_OFF) / 4; u += NTHR) MISC[u] = 0u;
    __syncthreads();
    const int lo = args.ph_lo, hi = args.ph_hi;
    XcdBarrier bar; bar.bar = (unsigned*)(F.ap->ws + WS_CTL) + CW_BAR; bar.x = 0; bar.st = nullptr;
    if (hi - lo > 1) bar = xcd_barrier_post((unsigned*)(F.ap->ws + WS_CTL) + CW_BAR, MISC + 8);
#define IN(k) (lo <= (k) && (k) < hi)
#define SEAM(k) do { if (IN((k) + 1)) xcd_barrier(bar); } while (0)
    if (IN(0)) { p0_prologue(F); SEAM(0); }
    for (int l = 0; l < DEPTH; ++l) {
        const int pb = 1 + PH_PER_LAYER * l;
        if (pb + PH_PER_LAYER <= lo || pb >= hi) continue;
#define mods_l ((const float*)(F.ap->ws + WS_MODS) + (size_t)l * 2 * MODW)
#define wl (F.ap->ws + WS_W + (size_t)l * WL_BYTES)
#define nw (F.ap->in[I_NORMW] + (size_t)l * 3 * DM)
#define xin0 ((l == 0) ? F.ap->in[I_X] : (const float*)F.ap->out)
        if (IN(pb + 0)) { fresh(F); ph_modnorm(F, xin0, nw, mods_l, 0); SEAM(pb + 0); }
        if (IN(pb + 1)) { fresh(F); pg8::Gemm g{(const bf16*)(F.ap->ws + WS_HN), (const bf16*)(wl + WL_W13), MROWS, DFF2, DM}; pg8::StaticOrder S; S.init(MROWS, DFF2, F.G, (int)blockIdx.x);
            pg8::EpiSwiGLU E{(bf16*)(F.ap->ws + WS_H1), DFF}; pg8::gemm_phase<pg8::EpiSwiGLU, pg8::StaticOrder, true, true>(F.lds, g, S, E); SEAM(pb + 1); }
        if (IN(pb + 2)) { fresh(F); pg8::Gemm g{(const bf16*)(F.ap->ws + WS_H1), (const bf16*)(wl + WL_W2), MROWS, DM, DFF}; pg8::StaticOrder S; S.init(MROWS, DM, F.G, (int)blockIdx.x);
            pg8::EpiResid E{xin0, F.ap->out, DM, mods_l + 2 * DM, MODW, SEQ, 0.5f}; pg8::gemm_phase<pg8::EpiResid, pg8::StaticOrder, true, true>(F.lds, g, S, E); SEAM(pb + 2); }
        if (IN(pb + 3)) { fresh(F); ph_modnorm(F, F.ap->out, nw + DM, mods_l, 3); SEAM(pb + 3); }
        if (IN(pb + 4)) { fresh(F); pg8::Gemm g{(const bf16*)(F.ap->ws + WS_HN), (const bf16*)(wl + WL_WIN), MROWS, DINP, DM}; pg8::StaticOrder S; S.init(MROWS, DINP, F.G, (int)blockIdx.x);
            pg8::EpiInProj E{(bf16*)(F.ap->ws + WS_PROJ), DINP, (const float*)(F.ap->ws + WS_ROPE), (float*)(F.ap->ws + WS_DTR), PQ, PK, SEQ - 1};
            pg8::gemm_phase<pg8::EpiInProj, pg8::StaticOrder, true, true>(F.lds, g, S, E); SEAM(pb + 4); }
        if (IN(pb + 5)) { if (DUP(1)) { ph_states(F, l); xcd_barrier(bar); } ph_states(F, l); SEAM(pb + 5); }
        if (IN(pb + 6)) { if (DUP(5)) { ph_scan(F); xcd_barrier(bar); } ph_scan(F); SEAM(pb + 6); }
        if (IN(pb + 7)) { if (DUP(6)) { ph_outputs(F, l); xcd_barrier(bar); } ph_outputs(F, l); SEAM(pb + 7); }
        if (IN(pb + 8)) { fresh(F); pg8::Gemm g{(const bf16*)(F.ap->ws + WS_YMIX), (const bf16*)(wl + WL_WOUT), MROWS, DM, DM}; pg8::StaticOrder S; S.init(MROWS, DM, F.G, (int)blockIdx.x);
            build_rtab(F, S);
            pg8::EpiResid E{F.ap->out, F.ap->out, DM, mods_l + 5 * DM, MODW, SEQ, 1.0f};
            pg8::gemm_phase<pg8::EpiResid, pg8::StaticOrder, true, true, DSSD / 64>(F.lds, g, S, E, (const LAS float*)(F.lds + RTAB_OFF)); SEAM(pb + 8); }
        if (IN(pb + 9)) { fresh(F); ph_modnorm(F, F.ap->out, nw + 2 * DM, mods_l, 6); SEAM(pb + 9); }
        if (IN(pb + 10)) { fresh(F); pg8::Gemm g{(const bf16*)(F.ap->ws + WS_HN), (const bf16*)(wl + WL_W13 + W13_BYTES), MROWS, DFF2, DM}; pg8::StaticOrder S; S.init(MROWS, DFF2, F.G, (int)blockIdx.x);
            pg8::EpiSwiGLU E{(bf16*)(F.ap->ws + WS_H1), DFF}; pg8::gemm_phase<pg8::EpiSwiGLU, pg8::StaticOrder, true, true>(F.lds, g, S, E); SEAM(pb + 10); }
        if (IN(pb + 11)) { fresh(F); pg8::Gemm g{(const bf16*)(F.ap->ws + WS_H1), (const bf16*)(wl + WL_W2 + W2_BYTES), MROWS, DM, DFF}; pg8::StaticOrder S; S.init(MROWS, DM, F.G, (int)blockIdx.x);
            pg8::EpiResid E{F.ap->out, F.ap->out, DM, mods_l + 8 * DM, MODW, SEQ, 0.5f}; pg8::gemm_phase<pg8::EpiResid, pg8::StaticOrder, true, true>(F.lds, g, S, E); SEAM(pb + 11); }
    }
#undef mods_l
#undef wl
#undef nw
#undef xin0
    if (IN(NPH - 1)) ph_finalnorm(F);
#undef IN
#undef SEAM
}

#ifndef MK_PER_PHASE
#define MK_PER_PHASE 0
#endif
extern "C" void kernel_launch(void* const* d_in, const int* in_sizes, int n_in, void* d_out, int out_size, void* d_ws, size_t ws_size, hipStream_t stream) {
    static int grid = 0;
    if (grid == 0) {
        if (n_in != 18 || out_size != MROWS * DM || ws_size < WS_END) { fprintf(stderr, "kernel_launch: unexpected shapes (n_in %d out %d ws %zu need %zu)\n", n_in, out_size, ws_size, (size_t)WS_END); grid = -1; return; }
        int dev = 0, cus = 0, per_cu = 0;
        if (hipGetDevice(&dev) != hipSuccess || hipDeviceGetAttribute(&cus, hipDeviceAttributeMultiprocessorCount, dev) != hipSuccess) { grid = -1; return; }
        if (hipFuncSetAttribute((const void*)mk_fwd, hipFuncAttributeMaxDynamicSharedMemorySize, LDS_BYTES) != hipSuccess) { fprintf(stderr, "kernel_launch: hipFuncSetAttribute failed\n"); grid = -1; return; }
        if (hipOccupancyMaxActiveBlocksPerMultiprocessor(&per_cu, (const void*)mk_fwd, NTHR, LDS_BYTES) != hipSuccess || per_cu < 1) fprintf(stderr, "kernel_launch: occupancy query says %d\n", per_cu);
        (void)hipGetLastError();
        grid = cus;
        if (grid < 32) { fprintf(stderr, "kernel_launch: needs >= 32 CUs\n"); grid = -1; return; }
    }
    if (grid < 0) return;
    (void)in_sizes;
    if (hipMemsetAsync((char*)d_ws + WS_CTL, 0, CTL_ZERO_BYTES, stream) != hipSuccess) return;
    Args a{};
    for (int i = 0; i < 18; ++i) a.in[i] = (const float*)d_in[i];
    a.out = (float*)d_out; a.ws = (unsigned char*)d_ws;
#if MK_PER_PHASE
    for (int p = 0; p < NPH; ++p) { a.ph_lo = p; a.ph_hi = p + 1; hipLaunchKernelGGL(mk_fwd, dim3(grid), dim3(NTHR), LDS_BYTES, stream, a); }
#else
    a.ph_lo = 0; a.ph_hi = NPH;
    hipLaunchKernelGGL(mk_fwd, dim3(grid), dim3(NTHR), LDS_BYTES, stream, a);
#endif
}
```
